# Optimizing an MI355X kernel written in HIP

```python
import math
import jax, jax.numpy as jnp
from jax import lax
import numpy as np

D_MODEL = 1024
BATCH = 8
SEQ = 4096
DEPTH = 2

CHUNK = 64
Q_BLOCK = 128
N_MIXERS = 2
ATTN_HEADS = 8
ATTN_HEAD_DIM = D_MODEL // (2 * ATTN_HEADS)
ATTN_V_DIM = 2 * ATTN_HEAD_DIM
ROPE_THETA = 10000.0
LAMBDA_STD = 0.1
D_RNN = D_MODEL
RG_BLOCK = 256
RG_HEADS = D_RNN // RG_BLOCK
CONV_WIDTH = 4
RG_C = 8.0
D_FF = 4 * D_MODEL
NORM_EPS = 1e-6
SUBLN_EPS = 1e-5

kernel_name = "hybrid_diffattn_rglru_streaming"


def rmsnorm(x, g, eps=NORM_EPS):
    xf = x.astype(jnp.float32)
    y = xf * lax.rsqrt(jnp.mean(xf * xf, axis=-1, keepdims=True) + eps)
    return (y * g.astype(jnp.float32)).astype(x.dtype)


def rope(t, positions):
    d = t.shape[-1]
    inv_freq = 1.0 / (ROPE_THETA ** (jnp.arange(0, d, 2, dtype=jnp.float32) / d))
    ang = positions.astype(jnp.float32)[:, None] * inv_freq[None, :]
    cos = jnp.cos(ang)[:, None, None, :]
    sin = jnp.sin(ang)[:, None, None, :]
    tf = t.astype(jnp.float32)
    t1, t2 = tf[..., : d // 2], tf[..., d // 2:]
    out = jnp.concatenate([t1 * cos - t2 * sin, t2 * cos + t1 * sin], axis=-1)
    return out.astype(t.dtype)


def diff_attention(h, w_qkv, w_o, lq1, lk1, lq2, lk2, subln_g, lambda_init):
    B, S, _ = h.shape
    H, d = ATTN_HEADS, ATTN_HEAD_DIM
    qkv = h @ w_qkv
    q, k, v = jnp.split(qkv, 3, axis=-1)
    positions = jnp.arange(S, dtype=jnp.int32)
    q = rope(q.reshape(B, S, H, 2, d), positions) * (d ** -0.5)
    k = rope(k.reshape(B, S, H, 2, d), positions)
    v = v.reshape(B, S, H, ATTN_V_DIM)
    lam = (jnp.exp(jnp.sum(lq1.astype(jnp.float32) * lk1.astype(jnp.float32)))
           - jnp.exp(jnp.sum(lq2.astype(jnp.float32) * lk2.astype(jnp.float32)))
           + lambda_init)
    n_blk = S // Q_BLOCK
    q_blocks = q.reshape(B, n_blk, Q_BLOCK, H, 2, d).transpose(1, 0, 2, 3, 4, 5)
    k_chunk = jnp.arange(S) // CHUNK

    def one_block(args):
        qb, bi = args
        q_chunk = (bi * Q_BLOCK + jnp.arange(Q_BLOCK)) // CHUNK
        allowed = k_chunk[None, :] <= q_chunk[:, None]
        s = jnp.einsum('bqhcd,bkhcd->bhcqk', qb, k).astype(jnp.float32)
        s = jnp.where(allowed[None, None, None], s, -jnp.inf)
        p = jax.nn.softmax(s, axis=-1)
        a = p[:, :, 0] - lam * p[:, :, 1]
        return jnp.einsum('bhqk,bkhe->bqhe', a.astype(v.dtype), v)

    o = lax.map(one_block, (q_blocks, jnp.arange(n_blk)))
    o = o.transpose(1, 0, 2, 3, 4).reshape(B, S, H, ATTN_V_DIM)
    o = rmsnorm(o, subln_g, SUBLN_EPS) * (1.0 - lambda_init)
    return o.reshape(B, S, H * ATTN_V_DIM) @ w_o


def causal_depthwise_conv(x, w, b):
    S = x.shape[1]
    xp = jnp.pad(x, ((0, 0), (CONV_WIDTH - 1, 0), (0, 0)))
    y = sum(xp[:, j:j + S] * w[j] for j in range(CONV_WIDTH))
    return y + b


def _lru_combine(left, right):
    a1, b1 = left
    a2, b2 = right
    return a1 * a2, a2 * b1 + b2


def recurrent_block(h, w_x, w_y, conv_w, conv_b, w_a, b_a, w_i, b_i, lam_param, w_o):
    B, S, _ = h.shape
    gate_branch = jax.nn.gelu(h @ w_y)
    xb = causal_depthwise_conv(h @ w_x, conv_w, conv_b)
    xg = xb.reshape(B, S, RG_HEADS, RG_BLOCK)
    r = jax.nn.sigmoid((jnp.einsum('bsnc,ncd->bsnd', xg, w_a).reshape(B, S, D_RNN) + b_a).astype(jnp.float32))
    i = jax.nn.sigmoid((jnp.einsum('bsnc,ncd->bsnd', xg, w_i).reshape(B, S, D_RNN) + b_i).astype(jnp.float32))
    log_a = -RG_C * r * jax.nn.softplus(-lam_param.astype(jnp.float32))
    a = jnp.exp(log_a)
    mult = jnp.sqrt(-jnp.expm1(2.0 * log_a))
    u = mult * (i * xb.astype(jnp.float32))
    _, hs = lax.associative_scan(_lru_combine, (a, u), axis=1)
    return (hs.astype(h.dtype) * gate_branch) @ w_o


def sqrelu_mlp(h, w1, w2):
    return jnp.square(jax.nn.relu(h @ w1)) @ w2


def setup_inputs(seed: int = 0) -> dict:
    key = jax.random.key(seed)
    ks = iter(jax.random.split(key, 32))
    n_attn = (DEPTH + 1) // 2
    n_rec = DEPTH // 2
    f32 = jnp.float32

    def nrm(shape, fan_in):
        return jax.random.normal(next(ks), shape, f32) * (fan_in ** -0.5)

    def gain(shape):
        return 1.0 + 0.02 * jax.random.normal(next(ks), shape, f32)

    x = jax.random.normal(next(ks), (BATCH, SEQ, D_MODEL), f32)
    mix_norm_g = gain((DEPTH, D_MODEL))
    mlp_norm_g = gain((DEPTH, D_MODEL))
    attn_w_qkv = nrm((n_attn, D_MODEL, 3 * D_MODEL), D_MODEL)
    attn_w_o = nrm((n_attn, ATTN_HEADS * ATTN_V_DIM, D_MODEL), ATTN_HEADS * ATTN_V_DIM)
    attn_lq1 = LAMBDA_STD * jax.random.normal(next(ks), (n_attn, ATTN_HEAD_DIM), f32)
    attn_lk1 = LAMBDA_STD * jax.random.normal(next(ks), (n_attn, ATTN_HEAD_DIM), f32)
    attn_lq2 = LAMBDA_STD * jax.random.normal(next(ks), (n_attn, ATTN_HEAD_DIM), f32)
    attn_lk2 = LAMBDA_STD * jax.random.normal(next(ks), (n_attn, ATTN_HEAD_DIM), f32)
    attn_subln_g = gain((n_attn, ATTN_V_DIM))
    rec_w_x = nrm((n_rec, D_MODEL, D_RNN), D_MODEL)
    rec_w_y = nrm((n_rec, D_MODEL, D_RNN), D_MODEL)
    rec_conv_w = nrm((n_rec, CONV_WIDTH, D_RNN), CONV_WIDTH)
    rec_conv_b = 0.01 * jax.random.normal(next(ks), (n_rec, D_RNN), f32)
    rec_w_a = nrm((n_rec, RG_HEADS, RG_BLOCK, RG_BLOCK), RG_BLOCK)
    rec_b_a = 0.01 * jax.random.normal(next(ks), (n_rec, D_RNN), f32)
    rec_w_i = nrm((n_rec, RG_HEADS, RG_BLOCK, RG_BLOCK), RG_BLOCK)
    rec_b_i = 0.01 * jax.random.normal(next(ks), (n_rec, D_RNN), f32)
    u = jax.random.uniform(next(ks), (n_rec, D_RNN), f32, 0.9, 0.999)
    a_base = u ** (1.0 / RG_C)
    rec_lambda = jnp.log(a_base) - jnp.log1p(-a_base)
    rec_w_o = nrm((n_rec, D_RNN, D_MODEL), D_RNN)
    mlp_w1 = nrm((DEPTH, D_MODEL, D_FF), D_MODEL)
    mlp_w2 = nrm((DEPTH, D_FF, D_MODEL), D_FF)
    final_norm_g = gain((D_MODEL,))
    return {"x": x, "mix_norm_g": mix_norm_g, "mlp_norm_g": mlp_norm_g,
            "attn_w_qkv": attn_w_qkv, "attn_w_o": attn_w_o,
            "attn_lq1": attn_lq1, "attn_lk1": attn_lk1, "attn_lq2": attn_lq2, "attn_lk2": attn_lk2,
            "attn_subln_g": attn_subln_g,
            "rec_w_x": rec_w_x, "rec_w_y": rec_w_y, "rec_conv_w": rec_conv_w, "rec_conv_b": rec_conv_b,
            "rec_w_a": rec_w_a, "rec_b_a": rec_b_a, "rec_w_i": rec_w_i, "rec_b_i": rec_b_i,
            "rec_lambda": rec_lambda, "rec_w_o": rec_w_o,
            "mlp_w1": mlp_w1, "mlp_w2": mlp_w2, "final_norm_g": final_norm_g}


def reference(x, mix_norm_g, mlp_norm_g, attn_w_qkv, attn_w_o, attn_lq1, attn_lk1, attn_lq2, attn_lk2,
              attn_subln_g, rec_w_x, rec_w_y, rec_conv_w, rec_conv_b, rec_w_a, rec_b_a, rec_w_i, rec_b_i,
              rec_lambda, rec_w_o, mlp_w1, mlp_w2, final_norm_g):
    for layer in range(DEPTH):
        h = rmsnorm(x, mix_norm_g[layer])
        j = layer // N_MIXERS
        if layer % N_MIXERS == 0:
            lambda_init = 0.8 - 0.6 * math.exp(-0.3 * layer)
            x = x + diff_attention(h, attn_w_qkv[j], attn_w_o[j], attn_lq1[j], attn_lk1[j],
                                   attn_lq2[j], attn_lk2[j], attn_subln_g[j], lambda_init)
        else:
            x = x + recurrent_block(h, rec_w_x[j], rec_w_y[j], rec_conv_w[j], rec_conv_b[j],
                                    rec_w_a[j], rec_b_a[j], rec_w_i[j], rec_b_i[j],
                                    rec_lambda[j], rec_w_o[j])
        x = x + sqrelu_mlp(rmsnorm(x, mlp_norm_g[layer]), mlp_w1[layer], mlp_w2[layer])
    return rmsnorm(x, final_norm_g)
```

```cpp
#include <hip/hip_runtime.h>
#include <stdint.h>
#include <cstdio>

#define LAS __attribute__((address_space(3)))
typedef unsigned short bf16_t;
typedef float f32x4 __attribute__((ext_vector_type(4)));
typedef unsigned u32x4 __attribute__((ext_vector_type(4)));
typedef unsigned u32x2 __attribute__((ext_vector_type(2)));

constexpr int BATCH = 8, SEQ = 4096, DM = 1024, FF = 4096, M = BATCH * SEQ;
constexpr int NH = 8;
constexpr float NORM_EPS = 1e-6f, SUBLN_EPS = 1e-5f;
constexpr float LAMBDA_INIT = 0.2f;
constexpr float C2 = 0.18033688011112042f;

constexpr size_t MiB = 1u << 20;
constexpr size_t WS_CTL = 0, CTL_ZERO_BYTES = 2 * MiB;
constexpr size_t WS_SSQ = 1 * MiB;
constexpr size_t WS_PAR = 2 * MiB;
constexpr size_t WS_ROPE = 3 * MiB;
constexpr size_t WS_WQKV = 4 * MiB, WS_WO = 10 * MiB, WS_W1 = 12 * MiB  , WS_W2 = 28 * MiB  , WS_WYX = 44 * MiB, WS_WG = 48 * MiB, WS_WRO = 49 * MiB;
constexpr size_t WS_XB = 52 * MiB;
constexpr size_t WS_R = 116 * MiB;
constexpr size_t WS_Q = WS_R, WS_K = WS_R + 64 * MiB, WS_V = WS_R + 128 * MiB, WS_H = WS_R;
constexpr size_t WS_Y = WS_R, WS_XC = WS_R + 64 * MiB, WS_XP = WS_R + 128 * MiB, WS_LAU = WS_R + 128 * MiB;
constexpr size_t WS_END = WS_R + 256 * MiB;

struct Params { const float* in[23]; float* out; unsigned char* ws; };

enum { I_X = 0, I_MIXG, I_MLPG, I_WQKV, I_WO, I_LQ1, I_LK1, I_LQ2, I_LK2, I_SUBG, I_RWX, I_RWY, I_CONVW, I_CONVB, I_RWA, I_RBA, I_RWI, I_RBI, I_RLAM, I_RWO, I_W1, I_W2, I_FING };

__device__ __forceinline__ float bf2f(unsigned b) { return __uint_as_float(b << 16); }
__device__ __forceinline__ unsigned f2bf(float f) { unsigned u = __float_as_uint(f); return (u + 0x7fffu + ((u >> 16) & 1u)) >> 16; }
__device__ __forceinline__ unsigned pk2(float lo, float hi) { return f2bf(lo) | (f2bf(hi) << 16); }
__device__ __forceinline__ u32x4 pk8(f32x4 a, f32x4 b) { u32x4 w; w.x = pk2(a[0], a[1]); w.y = pk2(a[2], a[3]); w.z = pk2(b[0], b[1]); w.w = pk2(b[2], b[3]); return w; }
__device__ __forceinline__ void unpk8(u32x4 w, float* f) { f[0] = bf2f(w.x & 0xffffu); f[1] = bf2f(w.x >> 16); f[2] = bf2f(w.y & 0xffffu); f[3] = bf2f(w.y >> 16);
    f[4] = bf2f(w.z & 0xffffu); f[5] = bf2f(w.z >> 16); f[6] = bf2f(w.w & 0xffffu); f[7] = bf2f(w.w >> 16); }
__device__ __forceinline__ float wave_sum(float v) {
#pragma unroll
    for (int o = 1; o < 64; o <<= 1) v += __shfl_xor(v, o);
    return v;
}
__device__ __forceinline__ float sigmoidf_(float x) { return 1.0f / (1.0f + __expf(-x)); }
__device__ __forceinline__ float gelu_tanh(float x) { const float z = 0.7978845608028654f * (x + 0.044715f * x * x * x); return x / (1.0f + __expf(-2.0f * z)); }

__device__ __forceinline__ int rope_phys(int d) { return d < 32 ? 8 * (d >> 2) + (d & 3) : 8 * ((d - 32) >> 2) + 4 + (d & 3); }

__device__ const double INV_FREQ[32] = {1.0, 0.7498942093324559, 0.5623413251903491, 0.4216965034285822, 0.31622776601683794, 0.23713737056616552, 0.1778279410038923, 0.1333521432163324, 0.1,
    0.07498942093324558, 0.05623413251903491, 0.042169650342858224, 0.03162277660168379, 0.023713737056616554, 0.01778279410038923, 0.01333521432163324, 0.01, 0.007498942093324558,
    0.005623413251903491, 0.004216965034285823, 0.0031622776601683794, 0.0023713737056616554, 0.0017782794100389228, 0.001333521432163324, 0.001, 0.0007498942093324559,
    0.0005623413251903491, 0.00042169650342858224, 0.00031622776601683794, 0.00023713737056616554, 0.00017782794100389227, 0.0001333521432163324};

__device__ __forceinline__ void sincos_d(double ang, float& s, float& c) {
    const double k = __builtin_rint(ang * 0.6366197723675814);
    const double r = ang - k * 1.5707963267948966;
    const double r2 = r * r;
    double sp = -1.0 / 1307674368000.0; sp = sp * r2 + 1.0 / 6227020800.0; sp = sp * r2 - 1.0 / 39916800.0; sp = sp * r2 + 1.0 / 362880.0; sp = sp * r2 - 1.0 / 5040.0; sp = sp * r2 + 1.0 / 120.0; sp = sp * r2 - 1.0 / 6.0; sp = sp * r2 + 1.0;
    const double sn = sp * r;
    double cp = 1.0 / 87178291200.0; cp = cp * r2 - 1.0 / 479001600.0; cp = cp * r2 + 1.0 / 3628800.0; cp = cp * r2 - 1.0 / 40320.0; cp = cp * r2 + 1.0 / 720.0; cp = cp * r2 - 1.0 / 24.0; cp = cp * r2 + 0.5; const double cs = 1.0 - cp * r2;
    const int q = ((int)k) & 3;
    const double ss = (q == 0) ? sn : (q == 1) ? cs : (q == 2) ? -sn : -cs;
    const double cc = (q == 0) ? cs : (q == 1) ? -sn : (q == 2) ? -cs : sn;
    s = (float)ss; c = (float)cc;
}

template <class RowMap>
__device__ __forceinline__ void tr_item(const float* W, int N, int K, bf16_t* WT, const float* g, LAS float* scr, int item, int lane, RowMap rm) {
    const int nblk = N / 32, kb = item / nblk, nb = item % nblk, k0 = 64 * kb, n0 = 32 * nb;
#pragma unroll 8
    for (int i = 0; i < 32; ++i) { const int kk = 2 * i + (lane >> 5); float v = W[(size_t)(k0 + kk) * N + n0 + (lane & 31)]; if (g) v *= g[k0 + kk]; scr[kk * 33 + (lane & 31)] = v; }
    asm volatile("s_waitcnt lgkmcnt(0)" ::: "memory");
    const int c = lane & 7;
#pragma unroll
    for (int j = 0; j < 4; ++j) { const int n = (lane >> 3) + 8 * j; const LAS float* s = scr + (8 * c) * 33 + n;
        u32x4 o; o.x = pk2(s[0 * 33], s[1 * 33]); o.y = pk2(s[2 * 33], s[3 * 33]); o.z = pk2(s[4 * 33], s[5 * 33]); o.w = pk2(s[6 * 33], s[7 * 33]);
        *(u32x4*)(WT + (size_t)rm(n0 + n) * K + k0 + 8 * c) = o; }
    asm volatile("s_waitcnt lgkmcnt(0)" ::: "memory");
}
struct MapId { int base; __device__ __forceinline__ int operator()(int n) const { return base + n; } };
struct MapQKV { __device__ __forceinline__ int operator()(int n) const { return n < 2048 ? (n & ~63) + rope_phys(n & 63) : n; } };
struct MapGate { int base; __device__ __forceinline__ int operator()(int d) const { return base + 8 * (d >> 2) + (d & 3); } };

__device__ __forceinline__ void prologue_work(const Params& p, int gw, int nw, int lane, LAS float* scr) {
    unsigned char* ws = p.ws;
    constexpr int IT_QKV = 16 * 96, IT_SQ = 16 * 32, IT_W1 = 16 * 128, IT_W2 = 64 * 32, IT_G = 4 * 8;
    constexpr int NIT = IT_QKV + IT_SQ + 2 * IT_W1 + 2 * IT_W2 + 2 * IT_SQ + 8 * IT_G + IT_SQ;
    for (int it = gw; it < NIT; it += nw) {
        int r = it;
        if (r < IT_QKV) { tr_item(p.in[I_WQKV], 3072, 1024, (bf16_t*)(ws + WS_WQKV), p.in[I_MIXG], scr, r, lane, MapQKV{}); continue; } r -= IT_QKV;
        if (r < IT_SQ) { tr_item(p.in[I_WO], 1024, 1024, (bf16_t*)(ws + WS_WO), nullptr, scr, r, lane, MapId{0}); continue; } r -= IT_SQ;
        if (r < 2 * IT_W1) { const int l = r / IT_W1; tr_item(p.in[I_W1] + (size_t)l * 1024 * 4096, 4096, 1024, (bf16_t*)(ws + WS_W1 + l * 8 * MiB), p.in[I_MLPG] + l * 1024, scr, r % IT_W1, lane, MapId{0}); continue; } r -= 2 * IT_W1;
        if (r < 2 * IT_W2) { const int l = r / IT_W2; tr_item(p.in[I_W2] + (size_t)l * 1024 * 4096, 1024, 4096, (bf16_t*)(ws + WS_W2 + l * 8 * MiB), nullptr, scr, r % IT_W2, lane, MapId{0}); continue; } r -= 2 * IT_W2;
        if (r < IT_SQ) { tr_item(p.in[I_RWY], 1024, 1024, (bf16_t*)(ws + WS_WYX), p.in[I_MIXG] + 1024, scr, r, lane, MapId{0}); continue; } r -= IT_SQ;
        if (r < IT_SQ) { tr_item(p.in[I_RWX], 1024, 1024, (bf16_t*)(ws + WS_WYX), p.in[I_MIXG] + 1024, scr, r, lane, MapId{1024}); continue; } r -= IT_SQ;
        if (r < 8 * IT_G) { const int w = r / IT_G, grp = w & 3, isi = w >> 2;
            tr_item(p.in[isi ? I_RWI : I_RWA] + (size_t)grp * 65536, 256, 256, (bf16_t*)(ws + WS_WG), nullptr, scr, r % IT_G, lane, MapGate{grp * 512 + isi * 4}); continue; } r -= 8 * IT_G;
        tr_item(p.in[I_RWO], 1024, 1024, (bf16_t*)(ws + WS_WRO), nullptr, scr, r, lane, MapId{0});
    }
    float* par = (float*)(ws + WS_PAR);
    float* cosT = (float*)(ws + WS_ROPE); float* sinT = cosT + 4096 * 32;
    for (int e = gw * 64 + lane; e < 4096 * 32; e += nw * 64) { const int pos = e >> 5, i = e & 31; float s, c; sincos_d((double)pos * INV_FREQ[i], s, c); cosT[e] = c; sinT[e] = s; }
    for (int c = gw * 64 + lane; c < 1024; c += nw * 64) {
        const float x = -p.in[I_RLAM][c]; const float z = __expf(-fabsf(x));
        const float l1p = (z < 0.02f) ? z * (1.0f + z * (-0.5f + z * (0.33333333f + z * (-0.25f + z * 0.2f)))) : __logf(1.0f + z);
        par[256 + c] = 8.0f * (fmaxf(x, 0.f) + l1p);
    }
    if (gw == 0) { float a = p.in[I_LQ1][lane] * p.in[I_LK1][lane], b = p.in[I_LQ2][lane] * p.in[I_LK2][lane]; a = wave_sum(a); b = wave_sum(b);
        if (lane == 0) par[0] = expf(a) - expf(b) + LAMBDA_INIT; }
    bf16_t* XB = (bf16_t*)(ws + WS_XB); float* ssq0 = (float*)(ws + WS_SSQ);
    for (int m = gw; m < M; m += nw) {
        const f32x4* xr = (const f32x4*)(p.in[I_X] + (size_t)m * DM) + lane; float s = 0.f;
        u32x2* o8 = (u32x2*)(XB + (size_t)m * DM) + lane;
#pragma unroll
        for (int j = 0; j < 4; ++j) { const f32x4 v = xr[64 * j]; s += (v.x * v.x + v.y * v.y) + (v.z * v.z + v.w * v.w); u32x2 w; w.x = pk2(v.x, v.y); w.y = pk2(v.z, v.w); o8[64 * j] = w; }
        s = wave_sum(s); if (lane == 0) ssq0[m] = s;
    }
}

struct EpiQKV {
    const float* ssq; const float* cosT; const float* sinT; bf16_t* Q;
    struct Ctx { float rs; int pos; };
    __device__ __forceinline__ Ctx row(int r) const { Ctx c; c.rs = rsqrtf(ssq[r] * (1.0f / DM) + NORM_EPS); c.pos = r & (SEQ - 1); return c; }
    __device__ __forceinline__ float apply(const Ctx& c, int r, int c0, f32x4 lo, f32x4 hi) const {
        lo = lo * c.rs; hi = hi * c.rs;
        const int sec = c0 >> 10, cc = c0 & 1023;
        if (sec < 2) { const int g = (c0 & 63) >> 3; const f32x4 cs = *(const f32x4*)(cosT + c.pos * 32 + 4 * g), sn = *(const f32x4*)(sinT + c.pos * 32 + 4 * g);
            f32x4 nlo = lo * cs - hi * sn, nhi = hi * cs + lo * sn; if (sec == 0) { nlo = nlo * C2; nhi = nhi * C2; } lo = nlo; hi = nhi; }
        *(u32x4*)(Q + (size_t)sec * ((size_t)M * DM) + (size_t)r * DM + cc) = pk8(lo, hi);
        return 0.f;
    }
    __device__ __forceinline__ void row_end(int, float) const {}
    static constexpr bool HAS_ROW_END = false;
};
struct EpiRes {
    const float* xin; float* xout; bf16_t* XB; float* ssq;
    struct Ctx { int dummy; };
    __device__ __forceinline__ Ctx row(int) const { return Ctx{0}; }
    __device__ __forceinline__ float apply(const Ctx&, int r, int c0, f32x4 lo, f32x4 hi) const {
        const size_t off = (size_t)r * DM + c0;
        const f32x4 a = *(const f32x4*)(xin + off) + lo, b = *(const f32x4*)(xin + off + 4) + hi;
        *(f32x4*)(xout + off) = a; *(f32x4*)(xout + off + 4) = b;
        if (XB) *(u32x4*)(XB + off) = pk8(a, b);
        return (a[0] * a[0] + a[1] * a[1]) + (a[2] * a[2] + a[3] * a[3]) + (b[0] * b[0] + b[1] * b[1]) + (b[2] * b[2] + b[3] * b[3]);
    }
    __device__ __forceinline__ void row_end(int r, float s) const { if (ssq) atomicAdd(ssq + r, s); }
    static constexpr bool HAS_ROW_END = true;
};
struct EpiUp {
    const float* ssq; bf16_t* H;
    struct Ctx { float rs; };
    __device__ __forceinline__ Ctx row(int r) const { return Ctx{rsqrtf(ssq[r] * (1.0f / DM) + NORM_EPS)}; }
    __device__ __forceinline__ float apply(const Ctx& c, int r, int c0, f32x4 lo, f32x4 hi) const {
        lo = lo * c.rs; hi = hi * c.rs;
#pragma unroll
        for (int j = 0; j < 4; ++j) { const float a = fmaxf(lo[j], 0.f), b = fmaxf(hi[j], 0.f); lo[j] = a * a; hi[j] = b * b; }
        *(u32x4*)(H + (size_t)r * FF + c0) = pk8(lo, hi); return 0.f;
    }
    __device__ __forceinline__ void row_end(int, float) const {}
    static constexpr bool HAS_ROW_END = false;
};
struct EpiRecIn {
    const float* ssq; bf16_t* Y; bf16_t* XP;
    struct Ctx { float rs; };
    __device__ __forceinline__ Ctx row(int r) const { return Ctx{rsqrtf(ssq[r] * (1.0f / DM) + NORM_EPS)}; }
    __device__ __forceinline__ float apply(const Ctx& c, int r, int c0, f32x4 lo, f32x4 hi) const {
        lo = lo * c.rs; hi = hi * c.rs;
        if (c0 < 1024) {
#pragma unroll
            for (int j = 0; j < 4; ++j) { lo[j] = gelu_tanh(lo[j]); hi[j] = gelu_tanh(hi[j]); }
            *(u32x4*)(Y + (size_t)r * DM + c0) = pk8(lo, hi);
        } else *(u32x4*)(XP + (size_t)r * DM + (c0 - 1024)) = pk8(lo, hi);
        return 0.f;
    }
    __device__ __forceinline__ void row_end(int, float) const {}
    static constexpr bool HAS_ROW_END = false;
};
struct EpiGates {
    const float* ba; const float* bi; const float* sp8; const bf16_t* XC; bf16_t* LAU;
    struct Ctx { int dummy; };
    __device__ __forceinline__ Ctx row(int) const { return Ctx{0}; }
    __device__ __forceinline__ float apply(const Ctx&, int r, int c0, f32x4 lo, f32x4 hi) const {
        const int grp = c0 >> 9, q = (c0 & 511) >> 3, ch = grp * 256 + 4 * q;
        const f32x4 b_a = *(const f32x4*)(ba + ch), b_i = *(const f32x4*)(bi + ch), sp = *(const f32x4*)(sp8 + ch);
        const u32x2 xw = *(const u32x2*)(XC + (size_t)r * DM + ch);
        const float xc[4] = {bf2f(xw.x & 0xffffu), bf2f(xw.x >> 16), bf2f(xw.y & 0xffffu), bf2f(xw.y >> 16)};
        unsigned w[4];
#pragma unroll
        for (int j = 0; j < 4; ++j) {
            const float rg = sigmoidf_(lo[j] + b_a[j]), ig = sigmoidf_(hi[j] + b_i[j]);
            const float la = -rg * sp[j];
            const float t = 2.0f * la;
            const float om = (t > -0.05f) ? -t * (1.0f + t * (0.5f + t * (0.16666667f + t * 0.041666668f))) : 1.0f - __expf(t);
            const float u = sqrtf(fmaxf(om, 0.f)) * ig * xc[j];
            w[j] = pk2(la, u);
        }
        u32x4 o; o.x = w[0]; o.y = w[1]; o.z = w[2]; o.w = w[3];
        *(u32x4*)(LAU + ((size_t)r * DM + ch) * 2) = o; return 0.f;
    }
    __device__ __forceinline__ void row_end(int, float) const {}
    static constexpr bool HAS_ROW_END = false;
};

__global__ void __launch_bounds__(256) k_prologue(Params p) {
    __shared__ float scr[4][64 * 33];
    const int lane = threadIdx.x & 63, wave = threadIdx.x >> 6;
    prologue_work(p, blockIdx.x * 4 + wave, gridDim.x * 4, lane, (LAS float*)&scr[wave][0]);
}

template <class Epi>
__global__ void __launch_bounds__(256) k_gemm_naive(const bf16_t* A, int lda, const bf16_t* Bt, int ldb, int K, int agrp, Epi epi) {
    __shared__ float As[32][68]; __shared__ float Bs[32][132];
    const int tid = threadIdx.x, tx = tid & 15, ty = tid >> 4;
    const int n0 = blockIdx.x * 128, m0 = blockIdx.y * 64;
    const int acol = agrp ? (n0 >> 9) * 256 : 0;
    float acc[4][8];
#pragma unroll
    for (int i = 0; i < 4; ++i)
#pragma unroll
        for (int j = 0; j < 8; ++j) acc[i][j] = 0.f;
    for (int k0 = 0; k0 < K; k0 += 32) {
        { const int row = tid >> 2, kc = (tid & 3) * 8; float f[8]; unpk8(*(const u32x4*)(A + (size_t)(m0 + row) * lda + acol + k0 + kc), f);
#pragma unroll
          for (int e = 0; e < 8; ++e) As[kc + e][row] = f[e]; }
#pragma unroll
        for (int j = 0; j < 2; ++j) { const int idx = tid + 256 * j, row = idx >> 2, kc = (idx & 3) * 8; float f[8]; unpk8(*(const u32x4*)(Bt + (size_t)(n0 + row) * ldb + k0 + kc), f);
#pragma unroll
          for (int e = 0; e < 8; ++e) Bs[kc + e][row] = f[e]; }
        __syncthreads();
#pragma unroll 4
        for (int k = 0; k < 32; ++k) {
            const f32x4 a = *(const f32x4*)&As[k][ty * 4]; const f32x4 b0 = *(const f32x4*)&Bs[k][tx * 8], b1 = *(const f32x4*)&Bs[k][tx * 8 + 4];
#pragma unroll
            for (int i = 0; i < 4; ++i) {
#pragma unroll
                for (int j = 0; j < 4; ++j) { acc[i][j] += a[i] * b0[j]; acc[i][4 + j] += a[i] * b1[j]; } }
        }
        __syncthreads();
    }
#pragma unroll
    for (int i = 0; i < 4; ++i) { const int r = m0 + ty * 4 + i; const typename Epi::Ctx c = epi.row(r);
        const float s = epi.apply(c, r, n0 + tx * 8, (f32x4){acc[i][0], acc[i][1], acc[i][2], acc[i][3]}, (f32x4){acc[i][4], acc[i][5], acc[i][6], acc[i][7]});
        if (Epi::HAS_ROW_END) epi.row_end(r, s); }
}

constexpr int ATN_LDS = (64 * 129 * 2 + 64 * 128 + 2 * 64 * 65 + 256) * 4;
__global__ void __launch_bounds__(256) k_attn_naive(Params p) {
    extern __shared__ __attribute__((aligned(16))) float sm[];
    float* Qs = sm; float* Ks = Qs + 64 * 129; float* Vs = Ks + 64 * 129; float* Ss = Vs + 64 * 128; float* scl = Ss + 2 * 64 * 65; float* linv = scl + 128;
    const int tid = threadIdx.x;
    const int wg = blockIdx.x; const int qc = 63 - (wg >> 6), bh = wg & 63, b = bh >> 3, h = bh & 7;
    const bf16_t* Qg = (const bf16_t*)(p.ws + WS_Q); const bf16_t* Kg = (const bf16_t*)(p.ws + WS_K); const bf16_t* Vg = (const bf16_t*)(p.ws + WS_V);
    bf16_t* Og = (bf16_t*)(p.ws + WS_Q);
    const float lam = ((const float*)(p.ws + WS_PAR))[0];
    const size_t rowq = (size_t)b * SEQ + qc * 64;
#pragma unroll
    for (int i = 0; i < 4; ++i) { const int idx = tid + 256 * i, row = idx >> 4, pc = idx & 15; float f[8]; unpk8(*(const u32x4*)(Qg + (rowq + row) * DM + h * 128 + pc * 8), f);
#pragma unroll
        for (int e = 0; e < 8; ++e) Qs[row * 129 + pc * 8 + e] = f[e]; }
    const int r = tid >> 2, part = tid & 3;
    float o1[32], o2[32];
#pragma unroll
    for (int j = 0; j < 32; ++j) { o1[j] = 0.f; o2[j] = 0.f; }
    float mrun = -INFINITY, lrun = 0.f;
    for (int jt = 0; jt <= qc; ++jt) {
        const size_t rowk = (size_t)b * SEQ + jt * 64;
        __syncthreads();
#pragma unroll
        for (int i = 0; i < 4; ++i) { const int idx = tid + 256 * i, row = idx >> 4, pc = idx & 15; float f[8];
            unpk8(*(const u32x4*)(Kg + (rowk + row) * DM + h * 128 + pc * 8), f);
#pragma unroll
            for (int e = 0; e < 8; ++e) Ks[row * 129 + pc * 8 + e] = f[e];
            unpk8(*(const u32x4*)(Vg + (rowk + row) * DM + h * 128 + pc * 8), f);
#pragma unroll
            for (int e = 0; e < 8; ++e) Vs[row * 128 + pc * 8 + e] = f[e]; }
        __syncthreads();
#pragma unroll
        for (int c = 0; c < 2; ++c) {
            float acc[16];
#pragma unroll
            for (int kk = 0; kk < 16; ++kk) acc[kk] = 0.f;
            for (int d = 0; d < 64; ++d) { const float qv = Qs[r * 129 + c * 64 + d];
#pragma unroll
                for (int kk = 0; kk < 16; ++kk) acc[kk] += qv * Ks[(part * 16 + kk) * 129 + c * 64 + d]; }
#pragma unroll
            for (int kk = 0; kk < 16; ++kk) Ss[(c * 64 + r) * 65 + part * 16 + kk] = acc[kk];
        }
        __syncthreads();
        if (tid < 128) { float* s = Ss + tid * 65; float mx = -INFINITY;
            for (int k = 0; k < 64; ++k) mx = fmaxf(mx, s[k]);
            const float mn = fmaxf(mrun, mx), sc = exp2f(mrun - mn); float sum = 0.f;
            for (int k = 0; k < 64; ++k) { const float e = exp2f(s[k] - mn); s[k] = e; sum += e; }
            lrun = lrun * sc + sum; mrun = mn; scl[tid] = sc; }
        __syncthreads();
        { const float s1 = scl[r], s2 = scl[64 + r];
#pragma unroll
          for (int j = 0; j < 32; ++j) { o1[j] *= s1; o2[j] *= s2; }
          for (int k = 0; k < 64; ++k) { const float p1 = Ss[r * 65 + k], p2 = Ss[(64 + r) * 65 + k];
#pragma unroll
              for (int j4 = 0; j4 < 8; ++j4) { const f32x4 v = *(const f32x4*)&Vs[k * 128 + part * 32 + 4 * j4];
#pragma unroll
                  for (int e = 0; e < 4; ++e) { o1[4 * j4 + e] += p1 * v[e]; o2[4 * j4 + e] += p2 * v[e]; } } } }
    }
    __syncthreads();
    if (tid < 128) linv[tid] = 1.0f / lrun;
    __syncthreads();
    { const float i1 = linv[r], i2 = linv[64 + r] * lam; float ss = 0.f;
#pragma unroll
      for (int j = 0; j < 32; ++j) { o1[j] = o1[j] * i1 - o2[j] * i2; ss += o1[j] * o1[j]; }
      ss += __shfl_xor(ss, 1); ss += __shfl_xor(ss, 2);
      const float rn = rsqrtf(ss * (1.0f / 128.0f) + SUBLN_EPS) * (1.0f - LAMBDA_INIT);
      const float* g = p.in[I_SUBG] + part * 32;
      bf16_t* orow = Og + (rowq + r) * DM + h * 128 + part * 32;
#pragma unroll
      for (int j8 = 0; j8 < 4; ++j8) { f32x4 a, bq;
#pragma unroll
          for (int e = 0; e < 4; ++e) { a[e] = o1[8 * j8 + e] * rn * g[8 * j8 + e]; bq[e] = o1[8 * j8 + 4 + e] * rn * g[8 * j8 + 4 + e]; }
          *(u32x4*)(orow + 8 * j8) = pk8(a, bq); } }
}

__global__ void __launch_bounds__(256) k_conv(Params p) {
    const bf16_t* XP = (const bf16_t*)(p.ws + WS_XP); bf16_t* XC = (bf16_t*)(p.ws + WS_XC);
    const float* cw = p.in[I_CONVW]; const float* cb = p.in[I_CONVB];
    for (size_t i = (size_t)blockIdx.x * 256 + threadIdx.x; i < (size_t)M * 128; i += (size_t)gridDim.x * 256) {
        const int row = (int)(i >> 7), c = (int)(i & 127) * 8, t = row & (SEQ - 1);
        float acc[8];
#pragma unroll
        for (int e = 0; e < 8; ++e) acc[e] = cb[c + e];
#pragma unroll
        for (int j = 0; j < 4; ++j) { const int tt = t - 3 + j; if (tt >= 0) { float f[8]; unpk8(*(const u32x4*)(XP + (size_t)(row - 3 + j) * DM + c), f);
#pragma unroll
            for (int e = 0; e < 8; ++e) acc[e] += cw[j * DM + c + e] * f[e]; } }
        *(u32x4*)(XC + (size_t)row * DM + c) = pk8((f32x4){acc[0], acc[1], acc[2], acc[3]}, (f32x4){acc[4], acc[5], acc[6], acc[7]});
    }
}

__global__ void __launch_bounds__(256) k_scan_naive(Params p) {
    const unsigned* LAU = (const unsigned*)(p.ws + WS_LAU); bf16_t* Y = (bf16_t*)(p.ws + WS_Y);
    const int id = blockIdx.x * 256 + threadIdx.x; const int b = id >> 10, c = id & 1023;
    float h = 0.f;
    const size_t base = (size_t)b * SEQ * DM + c;
#pragma unroll 8
    for (int t = 0; t < SEQ; ++t) { const unsigned w = LAU[base + (size_t)t * DM]; const float la = bf2f(w & 0xffffu), u = bf2f(w >> 16);
        h = __expf(la) * h + u; const float y = bf2f(Y[base + (size_t)t * DM]); Y[base + (size_t)t * DM] = (bf16_t)f2bf(h * y); }
}

__global__ void __launch_bounds__(256) k_final_norm(Params p) {
    const int lane = threadIdx.x & 63; const int gw = blockIdx.x * 4 + (threadIdx.x >> 6), nw = gridDim.x * 4;
    const f32x4* g4 = (const f32x4*)p.in[I_FING] + lane;
    for (int m = gw; m < M; m += nw) { f32x4* xr = (f32x4*)(p.out + (size_t)m * DM) + lane; f32x4 v[4]; float s = 0.f;
#pragma unroll
        for (int j = 0; j < 4; ++j) { v[j] = xr[64 * j]; s += (v[j].x * v[j].x + v[j].y * v[j].y) + (v[j].z * v[j].z + v[j].w * v[j].w); }
        const float rs = rsqrtf(wave_sum(s) * (1.0f / DM) + NORM_EPS);
#pragma unroll
        for (int j = 0; j < 4; ++j) xr[64 * j] = v[j] * rs * g4[64 * j]; }
}

extern "C" void kernel_launch(void* const* d_in, const int* in_sizes, int n_in, void* d_out, int out_size, void* d_ws, size_t ws_size, hipStream_t stream) {
    static int ok = 0;
    if (ok == 0) {
        if (n_in != 23 || in_sizes[0] != M * DM || out_size != M * DM || ws_size < WS_END) { fprintf(stderr, "kernel_launch: unexpected shapes (n_in %d, in0 %d, out %d, ws %zu)\n", n_in, n_in > 0 ? in_sizes[0] : -1, out_size, ws_size); ok = -1; return; }
        if (hipFuncSetAttribute((const void*)k_attn_naive, hipFuncAttributeMaxDynamicSharedMemorySize, ATN_LDS) != hipSuccess) { fprintf(stderr, "kernel_launch: hipFuncSetAttribute failed\n"); ok = -1; return; }
        ok = 1;
    }
    if (ok < 0) return;
    Params p{};
    for (int i = 0; i < 23; ++i) p.in[i] = (const float*)d_in[i];
    p.out = (float*)d_out; p.ws = (unsigned char*)d_ws;
    unsigned char* ws = p.ws;
    (void)hipMemsetAsync(ws + WS_CTL, 0, CTL_ZERO_BYTES, stream);
    float* ssq = (float*)(ws + WS_SSQ); float* par = (float*)(ws + WS_PAR);
    const float* cosT = (const float*)(ws + WS_ROPE); const float* sinT = cosT + 4096 * 32;
    bf16_t* XB = (bf16_t*)(ws + WS_XB);
    k_prologue<<<1024, 256, 0, stream>>>(p);
    k_gemm_naive<EpiQKV><<<dim3(3072 / 128, M / 64), 256, 0, stream>>>(XB, DM, (const bf16_t*)(ws + WS_WQKV), DM, DM, 0, EpiQKV{ssq, cosT, sinT, (bf16_t*)(ws + WS_Q)});
    k_attn_naive<<<4096, 256, ATN_LDS, stream>>>(p);
    k_gemm_naive<EpiRes><<<dim3(DM / 128, M / 64), 256, 0, stream>>>((const bf16_t*)(ws + WS_Q), DM, (const bf16_t*)(ws + WS_WO), DM, DM, 0, EpiRes{p.in[I_X], p.out, XB, ssq + M});
    k_gemm_naive<EpiUp><<<dim3(FF / 128, M / 64), 256, 0, stream>>>(XB, DM, (const bf16_t*)(ws + WS_W1), DM, DM, 0, EpiUp{ssq + M, (bf16_t*)(ws + WS_H)});
    k_gemm_naive<EpiRes><<<dim3(DM / 128, M / 64), 256, 0, stream>>>((const bf16_t*)(ws + WS_H), FF, (const bf16_t*)(ws + WS_W2), FF, FF, 0, EpiRes{p.out, p.out, XB, ssq + 2 * M});
    k_gemm_naive<EpiRecIn><<<dim3(2048 / 128, M / 64), 256, 0, stream>>>(XB, DM, (const bf16_t*)(ws + WS_WYX), DM, DM, 0, EpiRecIn{ssq + 2 * M, (bf16_t*)(ws + WS_Y), (bf16_t*)(ws + WS_XP)});
    k_conv<<<2048, 256, 0, stream>>>(p);
    k_gemm_naive<EpiGates><<<dim3(2048 / 128, M / 64), 256, 0, stream>>>((const bf16_t*)(ws + WS_XC), DM, (const bf16_t*)(ws + WS_WG), 256, 256, 1,
        EpiGates{p.in[I_RBA], p.in[I_RBI], par + 256, (const bf16_t*)(ws + WS_XC), (bf16_t*)(ws + WS_LAU)});
    k_scan_naive<<<BATCH * DM / 256, 256, 0, stream>>>(p);
    k_gemm_naive<EpiRes><<<dim3(DM / 128, M / 64), 256, 0, stream>>>((const bf16_t*)(ws + WS_Y), DM, (const bf16_t*)(ws + WS_WRO), DM, DM, 0, EpiRes{p.out, p.out, XB, ssq + 3 * M});
    k_gemm_naive<EpiUp><<<dim3(FF / 128, M / 64), 256, 0, stream>>>(XB, DM, (const bf16_t*)(ws + WS_W1 + 8 * MiB), DM, DM, 0, EpiUp{ssq + 3 * M, (bf16_t*)(ws + WS_H)});
    k_gemm_naive<EpiRes><<<dim3(DM / 128, M / 64), 256, 0, stream>>>((const bf16_t*)(ws + WS_H), FF, (const bf16_t*)(ws + WS_W2 + 8 * MiB), FF, FF, 0, EpiRes{p.out, p.out, nullptr, nullptr});
    k_final_norm<<<2048, 256, 0, stream>>>(p);
}
```

```cpp
#include <hip/hip_runtime.h>
#include <stdint.h>
#include <cstdio>

#define LAS __attribute__((address_space(3)))
typedef unsigned short bf16_t;
typedef float f32x4 __attribute__((ext_vector_type(4)));
typedef unsigned u32x4 __attribute__((ext_vector_type(4)));
typedef unsigned u32x2 __attribute__((ext_vector_type(2)));

constexpr int BATCH = 8, SEQ = 4096, DM = 1024, FF = 4096, M = BATCH * SEQ;
constexpr int NH = 8;
constexpr float NORM_EPS = 1e-6f, SUBLN_EPS = 1e-5f;
constexpr float LAMBDA_INIT = 0.2f;
constexpr float C2 = 0.18033688011112042f;

constexpr size_t MiB = 1u << 20;
constexpr size_t WS_CTL = 0, CTL_ZERO_BYTES = 2 * MiB;
constexpr size_t WS_SSQ = 1 * MiB;
constexpr size_t WS_PAR = 2 * MiB;
constexpr size_t WS_ROPE = 3 * MiB;
constexpr size_t WS_WQKV = 4 * MiB, WS_WO = 10 * MiB, WS_W1 = 12 * MiB  , WS_W2 = 28 * MiB  , WS_WYX = 44 * MiB, WS_WG = 48 * MiB, WS_WRO = 49 * MiB;
constexpr size_t WS_XB = 52 * MiB;
constexpr size_t WS_R = 116 * MiB;
constexpr size_t WS_Q = WS_R, WS_K = WS_R + 64 * MiB, WS_V = WS_R + 128 * MiB, WS_H = WS_R;
constexpr size_t WS_Y = WS_R, WS_XC = WS_R + 64 * MiB, WS_XP = WS_R + 128 * MiB, WS_LAU = WS_R + 128 * MiB;
constexpr size_t WS_END = WS_R + 256 * MiB;

struct Params { const float* in[23]; float* out; unsigned char* ws; };

enum { I_X = 0, I_MIXG, I_MLPG, I_WQKV, I_WO, I_LQ1, I_LK1, I_LQ2, I_LK2, I_SUBG, I_RWX, I_RWY, I_CONVW, I_CONVB, I_RWA, I_RBA, I_RWI, I_RBI, I_RLAM, I_RWO, I_W1, I_W2, I_FING };

__device__ __forceinline__ float bf2f(unsigned b) { return __uint_as_float(b << 16); }
__device__ __forceinline__ unsigned f2bf(float f) { unsigned u = __float_as_uint(f); return (u + 0x7fffu + ((u >> 16) & 1u)) >> 16; }
__device__ __forceinline__ unsigned pk2(float lo, float hi) { return f2bf(lo) | (f2bf(hi) << 16); }
__device__ __forceinline__ u32x4 pk8(f32x4 a, f32x4 b) { u32x4 w; w.x = pk2(a[0], a[1]); w.y = pk2(a[2], a[3]); w.z = pk2(b[0], b[1]); w.w = pk2(b[2], b[3]); return w; }
__device__ __forceinline__ void unpk8(u32x4 w, float* f) { f[0] = bf2f(w.x & 0xffffu); f[1] = bf2f(w.x >> 16); f[2] = bf2f(w.y & 0xffffu); f[3] = bf2f(w.y >> 16);
    f[4] = bf2f(w.z & 0xffffu); f[5] = bf2f(w.z >> 16); f[6] = bf2f(w.w & 0xffffu); f[7] = bf2f(w.w >> 16); }
__device__ __forceinline__ float wave_sum(float v) {
#pragma unroll
    for (int o = 1; o < 64; o <<= 1) v += __shfl_xor(v, o);
    return v;
}
__device__ __forceinline__ float sigmoidf_(float x) { return 1.0f / (1.0f + __expf(-x)); }
__device__ __forceinline__ float gelu_tanh(float x) { const float z = 0.7978845608028654f * (x + 0.044715f * x * x * x); return x / (1.0f + __expf(-2.0f * z)); }

__device__ __forceinline__ int rope_phys(int d) { return d < 32 ? 8 * (d >> 2) + (d & 3) : 8 * ((d - 32) >> 2) + 4 + (d & 3); }

__device__ const double INV_FREQ[32] = {1.0, 0.7498942093324559, 0.5623413251903491, 0.4216965034285822, 0.31622776601683794, 0.23713737056616552, 0.1778279410038923, 0.1333521432163324, 0.1,
    0.07498942093324558, 0.05623413251903491, 0.042169650342858224, 0.03162277660168379, 0.023713737056616554, 0.01778279410038923, 0.01333521432163324, 0.01, 0.007498942093324558,
    0.005623413251903491, 0.004216965034285823, 0.0031622776601683794, 0.0023713737056616554, 0.0017782794100389228, 0.001333521432163324, 0.001, 0.0007498942093324559,
    0.0005623413251903491, 0.00042169650342858224, 0.00031622776601683794, 0.00023713737056616554, 0.00017782794100389227, 0.0001333521432163324};

__device__ __forceinline__ void sincos_d(double ang, float& s, float& c) {
    const double k = __builtin_rint(ang * 0.6366197723675814);
    const double r = ang - k * 1.5707963267948966;
    const double r2 = r * r;
    double sp = -1.0 / 1307674368000.0; sp = sp * r2 + 1.0 / 6227020800.0; sp = sp * r2 - 1.0 / 39916800.0; sp = sp * r2 + 1.0 / 362880.0; sp = sp * r2 - 1.0 / 5040.0; sp = sp * r2 + 1.0 / 120.0; sp = sp * r2 - 1.0 / 6.0; sp = sp * r2 + 1.0;
    const double sn = sp * r;
    double cp = 1.0 / 87178291200.0; cp = cp * r2 - 1.0 / 479001600.0; cp = cp * r2 + 1.0 / 3628800.0; cp = cp * r2 - 1.0 / 40320.0; cp = cp * r2 + 1.0 / 720.0; cp = cp * r2 - 1.0 / 24.0; cp = cp * r2 + 0.5; const double cs = 1.0 - cp * r2;
    const int q = ((int)k) & 3;
    const double ss = (q == 0) ? sn : (q == 1) ? cs : (q == 2) ? -sn : -cs;
    const double cc = (q == 0) ? cs : (q == 1) ? -sn : (q == 2) ? -cs : sn;
    s = (float)ss; c = (float)cc;
}

template <class RowMap>
__device__ __forceinline__ void tr_item(const float* W, int N, int K, bf16_t* WT, const float* g, LAS float* scr, int item, int lane, RowMap rm) {
    const int nblk = N / 32, kb = item / nblk, nb = item % nblk, k0 = 64 * kb, n0 = 32 * nb;
#pragma unroll 8
    for (int i = 0; i < 32; ++i) { const int kk = 2 * i + (lane >> 5); float v = W[(size_t)(k0 + kk) * N + n0 + (lane & 31)]; if (g) v *= g[k0 + kk]; scr[kk * 33 + (lane & 31)] = v; }
    asm volatile("s_waitcnt lgkmcnt(0)" ::: "memory");
    const int c = lane & 7;
#pragma unroll
    for (int j = 0; j < 4; ++j) { const int n = (lane >> 3) + 8 * j; const LAS float* s = scr + (8 * c) * 33 + n;
        u32x4 o; o.x = pk2(s[0 * 33], s[1 * 33]); o.y = pk2(s[2 * 33], s[3 * 33]); o.z = pk2(s[4 * 33], s[5 * 33]); o.w = pk2(s[6 * 33], s[7 * 33]);
        *(u32x4*)(WT + (size_t)rm(n0 + n) * K + k0 + 8 * c) = o; }
    asm volatile("s_waitcnt lgkmcnt(0)" ::: "memory");
}
struct MapId { int base; __device__ __forceinline__ int operator()(int n) const { return base + n; } };
struct MapQKV { __device__ __forceinline__ int operator()(int n) const { return n < 2048 ? (n & ~63) + rope_phys(n & 63) : n; } };
struct MapGate { int base; __device__ __forceinline__ int operator()(int d) const { return base + 8 * (d >> 2) + (d & 3); } };

__device__ __forceinline__ void prologue_work(const Params& p, int gw, int nw, int lane, LAS float* scr) {
    unsigned char* ws = p.ws;
    constexpr int IT_QKV = 16 * 96, IT_SQ = 16 * 32, IT_W1 = 16 * 128, IT_W2 = 64 * 32, IT_G = 4 * 8;
    constexpr int NIT = IT_QKV + IT_SQ + 2 * IT_W1 + 2 * IT_W2 + 2 * IT_SQ + 8 * IT_G + IT_SQ;
    for (int it = gw; it < NIT; it += nw) {
        int r = it;
        if (r < IT_QKV) { tr_item(p.in[I_WQKV], 3072, 1024, (bf16_t*)(ws + WS_WQKV), p.in[I_MIXG], scr, r, lane, MapQKV{}); continue; } r -= IT_QKV;
        if (r < IT_SQ) { tr_item(p.in[I_WO], 1024, 1024, (bf16_t*)(ws + WS_WO), nullptr, scr, r, lane, MapId{0}); continue; } r -= IT_SQ;
        if (r < 2 * IT_W1) { const int l = r / IT_W1; tr_item(p.in[I_W1] + (size_t)l * 1024 * 4096, 4096, 1024, (bf16_t*)(ws + WS_W1 + l * 8 * MiB), p.in[I_MLPG] + l * 1024, scr, r % IT_W1, lane, MapId{0}); continue; } r -= 2 * IT_W1;
        if (r < 2 * IT_W2) { const int l = r / IT_W2; tr_item(p.in[I_W2] + (size_t)l * 1024 * 4096, 1024, 4096, (bf16_t*)(ws + WS_W2 + l * 8 * MiB), nullptr, scr, r % IT_W2, lane, MapId{0}); continue; } r -= 2 * IT_W2;
        if (r < IT_SQ) { tr_item(p.in[I_RWY], 1024, 1024, (bf16_t*)(ws + WS_WYX), p.in[I_MIXG] + 1024, scr, r, lane, MapId{0}); continue; } r -= IT_SQ;
        if (r < IT_SQ) { tr_item(p.in[I_RWX], 1024, 1024, (bf16_t*)(ws + WS_WYX), p.in[I_MIXG] + 1024, scr, r, lane, MapId{1024}); continue; } r -= IT_SQ;
        if (r < 8 * IT_G) { const int w = r / IT_G, grp = w & 3, isi = w >> 2;
            tr_item(p.in[isi ? I_RWI : I_RWA] + (size_t)grp * 65536, 256, 256, (bf16_t*)(ws + WS_WG), nullptr, scr, r % IT_G, lane, MapGate{grp * 512 + isi * 4}); continue; } r -= 8 * IT_G;
        tr_item(p.in[I_RWO], 1024, 1024, (bf16_t*)(ws + WS_WRO), nullptr, scr, r, lane, MapId{0});
    }
    float* par = (float*)(ws + WS_PAR);
    float* cosT = (float*)(ws + WS_ROPE); float* sinT = cosT + 4096 * 32;
    for (int e = gw * 64 + lane; e < 4096 * 32; e += nw * 64) { const int pos = e >> 5, i = e & 31; float s, c; sincos_d((double)pos * INV_FREQ[i], s, c); cosT[e] = c; sinT[e] = s; }
    for (int c = gw * 64 + lane; c < 1024; c += nw * 64) {
        const float x = -p.in[I_RLAM][c]; const float z = __expf(-fabsf(x));
        const float l1p = (z < 0.02f) ? z * (1.0f + z * (-0.5f + z * (0.33333333f + z * (-0.25f + z * 0.2f)))) : __logf(1.0f + z);
        par[256 + c] = 8.0f * (fmaxf(x, 0.f) + l1p);
    }
    if (gw == 0) { float a = p.in[I_LQ1][lane] * p.in[I_LK1][lane], b = p.in[I_LQ2][lane] * p.in[I_LK2][lane]; a = wave_sum(a); b = wave_sum(b);
        if (lane == 0) par[0] = expf(a) - expf(b) + LAMBDA_INIT; }
    bf16_t* XB = (bf16_t*)(ws + WS_XB); float* ssq0 = (float*)(ws + WS_SSQ);
    for (int m = gw; m < M; m += nw) {
        const f32x4* xr = (const f32x4*)(p.in[I_X] + (size_t)m * DM) + lane; float s = 0.f;
        u32x2* o8 = (u32x2*)(XB + (size_t)m * DM) + lane;
#pragma unroll
        for (int j = 0; j < 4; ++j) { const f32x4 v = xr[64 * j]; s += (v.x * v.x + v.y * v.y) + (v.z * v.z + v.w * v.w); u32x2 w; w.x = pk2(v.x, v.y); w.y = pk2(v.z, v.w); o8[64 * j] = w; }
        s = wave_sum(s); if (lane == 0) ssq0[m] = s;
    }
}

struct EpiQKV {
    const float* ssq; const float* cosT; const float* sinT; bf16_t* Q;
    struct Ctx { float rs; int pos; };
    __device__ __forceinline__ Ctx row(int r) const { Ctx c; c.rs = rsqrtf(ssq[r] * (1.0f / DM) + NORM_EPS); c.pos = r & (SEQ - 1); return c; }
    __device__ __forceinline__ float apply(const Ctx& c, int r, int c0, f32x4 lo, f32x4 hi) const {
        lo = lo * c.rs; hi = hi * c.rs;
        const int sec = c0 >> 10, cc = c0 & 1023;
        if (sec < 2) { const int g = (c0 & 63) >> 3; const f32x4 cs = *(const f32x4*)(cosT + c.pos * 32 + 4 * g), sn = *(const f32x4*)(sinT + c.pos * 32 + 4 * g);
            f32x4 nlo = lo * cs - hi * sn, nhi = hi * cs + lo * sn; if (sec == 0) { nlo = nlo * C2; nhi = nhi * C2; } lo = nlo; hi = nhi; }
        *(u32x4*)(Q + (size_t)sec * ((size_t)M * DM) + (size_t)r * DM + cc) = pk8(lo, hi);
        return 0.f;
    }
    __device__ __forceinline__ void row_end(int, float) const {}
    static constexpr bool HAS_ROW_END = false;
};
struct EpiRes {
    const float* xin; float* xout; bf16_t* XB; float* ssq;
    struct Ctx { int dummy; };
    __device__ __forceinline__ Ctx row(int) const { return Ctx{0}; }
    __device__ __forceinline__ float apply(const Ctx&, int r, int c0, f32x4 lo, f32x4 hi) const {
        const size_t off = (size_t)r * DM + c0;
        const f32x4 a = *(const f32x4*)(xin + off) + lo, b = *(const f32x4*)(xin + off + 4) + hi;
        *(f32x4*)(xout + off) = a; *(f32x4*)(xout + off + 4) = b;
        if (XB) *(u32x4*)(XB + off) = pk8(a, b);
        return (a[0] * a[0] + a[1] * a[1]) + (a[2] * a[2] + a[3] * a[3]) + (b[0] * b[0] + b[1] * b[1]) + (b[2] * b[2] + b[3] * b[3]);
    }
    __device__ __forceinline__ void row_end(int r, float s) const { if (ssq) atomicAdd(ssq + r, s); }
    static constexpr bool HAS_ROW_END = true;
};
struct EpiUp {
    const float* ssq; bf16_t* H;
    struct Ctx { float rs; };
    __device__ __forceinline__ Ctx row(int r) const { return Ctx{rsqrtf(ssq[r] * (1.0f / DM) + NORM_EPS)}; }
    __device__ __forceinline__ float apply(const Ctx& c, int r, int c0, f32x4 lo, f32x4 hi) const {
        lo = lo * c.rs; hi = hi * c.rs;
#pragma unroll
        for (int j = 0; j < 4; ++j) { const float a = fmaxf(lo[j], 0.f), b = fmaxf(hi[j], 0.f); lo[j] = a * a; hi[j] = b * b; }
        *(u32x4*)(H + (size_t)r * FF + c0) = pk8(lo, hi); return 0.f;
    }
    __device__ __forceinline__ void row_end(int, float) const {}
    static constexpr bool HAS_ROW_END = false;
};
struct EpiRecIn {
    const float* ssq; bf16_t* Y; bf16_t* XP;
    struct Ctx { float rs; };
    __device__ __forceinline__ Ctx row(int r) const { return Ctx{rsqrtf(ssq[r] * (1.0f / DM) + NORM_EPS)}; }
    __device__ __forceinline__ float apply(const Ctx& c, int r, int c0, f32x4 lo, f32x4 hi) const {
        lo = lo * c.rs; hi = hi * c.rs;
        if (c0 < 1024) {
#pragma unroll
            for (int j = 0; j < 4; ++j) { lo[j] = gelu_tanh(lo[j]); hi[j] = gelu_tanh(hi[j]); }
            *(u32x4*)(Y + (size_t)r * DM + c0) = pk8(lo, hi);
        } else *(u32x4*)(XP + (size_t)r * DM + (c0 - 1024)) = pk8(lo, hi);
        return 0.f;
    }
    __device__ __forceinline__ void row_end(int, float) const {}
    static constexpr bool HAS_ROW_END = false;
};
struct EpiGates {
    const float* ba; const float* bi; const float* sp8; const bf16_t* XC; bf16_t* LAU;
    struct Ctx { int dummy; };
    __device__ __forceinline__ Ctx row(int) const { return Ctx{0}; }
    __device__ __forceinline__ float apply(const Ctx&, int r, int c0, f32x4 lo, f32x4 hi) const {
        const int grp = c0 >> 9, q = (c0 & 511) >> 3, ch = grp * 256 + 4 * q;
        const f32x4 b_a = *(const f32x4*)(ba + ch), b_i = *(const f32x4*)(bi + ch), sp = *(const f32x4*)(sp8 + ch);
        const u32x2 xw = *(const u32x2*)(XC + (size_t)r * DM + ch);
        const float xc[4] = {bf2f(xw.x & 0xffffu), bf2f(xw.x >> 16), bf2f(xw.y & 0xffffu), bf2f(xw.y >> 16)};
        unsigned w[4];
#pragma unroll
        for (int j = 0; j < 4; ++j) {
            const float rg = sigmoidf_(lo[j] + b_a[j]), ig = sigmoidf_(hi[j] + b_i[j]);
            const float la = -rg * sp[j];
            const float t = 2.0f * la;
            const float om = (t > -0.05f) ? -t * (1.0f + t * (0.5f + t * (0.16666667f + t * 0.041666668f))) : 1.0f - __expf(t);
            const float u = sqrtf(fmaxf(om, 0.f)) * ig * xc[j];
            w[j] = pk2(la, u);
        }
        u32x4 o; o.x = w[0]; o.y = w[1]; o.z = w[2]; o.w = w[3];
        *(u32x4*)(LAU + ((size_t)r * DM + ch) * 2) = o; return 0.f;
    }
    __device__ __forceinline__ void row_end(int, float) const {}
    static constexpr bool HAS_ROW_END = false;
};

__global__ void __launch_bounds__(256) k_prologue(Params p) {
    __shared__ float scr[4][64 * 33];
    const int lane = threadIdx.x & 63, wave = threadIdx.x >> 6;
    prologue_work(p, blockIdx.x * 4 + wave, gridDim.x * 4, lane, (LAS float*)&scr[wave][0]);
}

template <class Epi>
__global__ void __launch_bounds__(256) k_gemm_naive(const bf16_t* A, int lda, const bf16_t* Bt, int ldb, int K, int agrp, Epi epi) {
    __shared__ float As[32][68]; __shared__ float Bs[32][132];
    const int tid = threadIdx.x, tx = tid & 15, ty = tid >> 4;
    const int n0 = blockIdx.x * 128, m0 = blockIdx.y * 64;
    const int acol = agrp ? (n0 >> 9) * 256 : 0;
    float acc[4][8];
#pragma unroll
    for (int i = 0; i < 4; ++i)
#pragma unroll
        for (int j = 0; j < 8; ++j) acc[i][j] = 0.f;
    for (int k0 = 0; k0 < K; k0 += 32) {
        { const int row = tid >> 2, kc = (tid & 3) * 8; float f[8]; unpk8(*(const u32x4*)(A + (size_t)(m0 + row) * lda + acol + k0 + kc), f);
#pragma unroll
          for (int e = 0; e < 8; ++e) As[kc + e][row] = f[e]; }
#pragma unroll
        for (int j = 0; j < 2; ++j) { const int idx = tid + 256 * j, row = idx >> 2, kc = (idx & 3) * 8; float f[8]; unpk8(*(const u32x4*)(Bt + (size_t)(n0 + row) * ldb + k0 + kc), f);
#pragma unroll
          for (int e = 0; e < 8; ++e) Bs[kc + e][row] = f[e]; }
        __syncthreads();
#pragma unroll 4
        for (int k = 0; k < 32; ++k) {
            const f32x4 a = *(const f32x4*)&As[k][ty * 4]; const f32x4 b0 = *(const f32x4*)&Bs[k][tx * 8], b1 = *(const f32x4*)&Bs[k][tx * 8 + 4];
#pragma unroll
            for (int i = 0; i < 4; ++i) {
#pragma unroll
                for (int j = 0; j < 4; ++j) { acc[i][j] += a[i] * b0[j]; acc[i][4 + j] += a[i] * b1[j]; } }
        }
        __syncthreads();
    }
#pragma unroll
    for (int i = 0; i < 4; ++i) { const int r = m0 + ty * 4 + i; const typename Epi::Ctx c = epi.row(r);
        const float s = epi.apply(c, r, n0 + tx * 8, (f32x4){acc[i][0], acc[i][1], acc[i][2], acc[i][3]}, (f32x4){acc[i][4], acc[i][5], acc[i][6], acc[i][7]});
        if (Epi::HAS_ROW_END) epi.row_end(r, s); }
}

constexpr int ATN_LDS = (64 * 129 * 2 + 64 * 128 + 2 * 64 * 65 + 256) * 4;
__global__ void __launch_bounds__(256) k_attn_naive(Params p) {
    extern __shared__ __attribute__((aligned(16))) float sm[];
    float* Qs = sm; float* Ks = Qs + 64 * 129; float* Vs = Ks + 64 * 129; float* Ss = Vs + 64 * 128; float* scl = Ss + 2 * 64 * 65; float* linv = scl + 128;
    const int tid = threadIdx.x;
    const int wg = blockIdx.x; const int qc = 63 - (wg >> 6), bh = wg & 63, b = bh >> 3, h = bh & 7;
    const bf16_t* Qg = (const bf16_t*)(p.ws + WS_Q); const bf16_t* Kg = (const bf16_t*)(p.ws + WS_K); const bf16_t* Vg = (const bf16_t*)(p.ws + WS_V);
    bf16_t* Og = (bf16_t*)(p.ws + WS_Q);
    const float lam = ((const float*)(p.ws + WS_PAR))[0];
    const size_t rowq = (size_t)b * SEQ + qc * 64;
#pragma unroll
    for (int i = 0; i < 4; ++i) { const int idx = tid + 256 * i, row = idx >> 4, pc = idx & 15; float f[8]; unpk8(*(const u32x4*)(Qg + (rowq + row) * DM + h * 128 + pc * 8), f);
#pragma unroll
        for (int e = 0; e < 8; ++e) Qs[row * 129 + pc * 8 + e] = f[e]; }
    const int r = tid >> 2, part = tid & 3;
    float o1[32], o2[32];
#pragma unroll
    for (int j = 0; j < 32; ++j) { o1[j] = 0.f; o2[j] = 0.f; }
    float mrun = -INFINITY, lrun = 0.f;
    for (int jt = 0; jt <= qc; ++jt) {
        const size_t rowk = (size_t)b * SEQ + jt * 64;
        __syncthreads();
#pragma unroll
        for (int i = 0; i < 4; ++i) { const int idx = tid + 256 * i, row = idx >> 4, pc = idx & 15; float f[8];
            unpk8(*(const u32x4*)(Kg + (rowk + row) * DM + h * 128 + pc * 8), f);
#pragma unroll
            for (int e = 0; e < 8; ++e) Ks[row * 129 + pc * 8 + e] = f[e];
            unpk8(*(const u32x4*)(Vg + (rowk + row) * DM + h * 128 + pc * 8), f);
#pragma unroll
            for (int e = 0; e < 8; ++e) Vs[row * 128 + pc * 8 + e] = f[e]; }
        __syncthreads();
#pragma unroll
        for (int c = 0; c < 2; ++c) {
            float acc[16];
#pragma unroll
            for (int kk = 0; kk < 16; ++kk) acc[kk] = 0.f;
            for (int d = 0; d < 64; ++d) { const float qv = Qs[r * 129 + c * 64 + d];
#pragma unroll
                for (int kk = 0; kk < 16; ++kk) acc[kk] += qv * Ks[(part * 16 + kk) * 129 + c * 64 + d]; }
#pragma unroll
            for (int kk = 0; kk < 16; ++kk) Ss[(c * 64 + r) * 65 + part * 16 + kk] = acc[kk];
        }
        __syncthreads();
        if (tid < 128) { float* s = Ss + tid * 65; float mx = -INFINITY;
            for (int k = 0; k < 64; ++k) mx = fmaxf(mx, s[k]);
            const float mn = fmaxf(mrun, mx), sc = exp2f(mrun - mn); float sum = 0.f;
            for (int k = 0; k < 64; ++k) { const float e = exp2f(s[k] - mn); s[k] = e; sum += e; }
            lrun = lrun * sc + sum; mrun = mn; scl[tid] = sc; }
        __syncthreads();
        { const float s1 = scl[r], s2 = scl[64 + r];
#pragma unroll
          for (int j = 0; j < 32; ++j) { o1[j] *= s1; o2[j] *= s2; }
          for (int k = 0; k < 64; ++k) { const float p1 = Ss[r * 65 + k], p2 = Ss[(64 + r) * 65 + k];
#pragma unroll
              for (int j4 = 0; j4 < 8; ++j4) { const f32x4 v = *(const f32x4*)&Vs[k * 128 + part * 32 + 4 * j4];
#pragma unroll
                  for (int e = 0; e < 4; ++e) { o1[4 * j4 + e] += p1 * v[e]; o2[4 * j4 + e] += p2 * v[e]; } } } }
    }
    __syncthreads();
    if (tid < 128) linv[tid] = 1.0f / lrun;
    __syncthreads();
    { const float i1 = linv[r], i2 = linv[64 + r] * lam; float ss = 0.f;
#pragma unroll
      for (int j = 0; j < 32; ++j) { o1[j] = o1[j] * i1 - o2[j] * i2; ss += o1[j] * o1[j]; }
      ss += __shfl_xor(ss, 1); ss += __shfl_xor(ss, 2);
      const float rn = rsqrtf(ss * (1.0f / 128.0f) + SUBLN_EPS) * (1.0f - LAMBDA_INIT);
      const float* g = p.in[I_SUBG] + part * 32;
      bf16_t* orow = Og + (rowq + r) * DM + h * 128 + part * 32;
#pragma unroll
      for (int j8 = 0; j8 < 4; ++j8) { f32x4 a, bq;
#pragma unroll
          for (int e = 0; e < 4; ++e) { a[e] = o1[8 * j8 + e] * rn * g[8 * j8 + e]; bq[e] = o1[8 * j8 + 4 + e] * rn * g[8 * j8 + 4 + e]; }
          *(u32x4*)(orow + 8 * j8) = pk8(a, bq); } }
}

__global__ void __launch_bounds__(256) k_conv(Params p) {
    const bf16_t* XP = (const bf16_t*)(p.ws + WS_XP); bf16_t* XC = (bf16_t*)(p.ws + WS_XC);
    const float* cw = p.in[I_CONVW]; const float* cb = p.in[I_CONVB];
    for (size_t i = (size_t)blockIdx.x * 256 + threadIdx.x; i < (size_t)M * 128; i += (size_t)gridDim.x * 256) {
        const int row = (int)(i >> 7), c = (int)(i & 127) * 8, t = row & (SEQ - 1);
        float acc[8];
#pragma unroll
        for (int e = 0; e < 8; ++e) acc[e] = cb[c + e];
#pragma unroll
        for (int j = 0; j < 4; ++j) { const int tt = t - 3 + j; if (tt >= 0) { float f[8]; unpk8(*(const u32x4*)(XP + (size_t)(row - 3 + j) * DM + c), f);
#pragma unroll
            for (int e = 0; e < 8; ++e) acc[e] += cw[j * DM + c + e] * f[e]; } }
        *(u32x4*)(XC + (size_t)row * DM + c) = pk8((f32x4){acc[0], acc[1], acc[2], acc[3]}, (f32x4){acc[4], acc[5], acc[6], acc[7]});
    }
}

__global__ void __launch_bounds__(256) k_scan_naive(Params p) {
    const unsigned* LAU = (const unsigned*)(p.ws + WS_LAU); bf16_t* Y = (bf16_t*)(p.ws + WS_Y);
    const int id = blockIdx.x * 256 + threadIdx.x; const int b = id >> 10, c = id & 1023;
    float h = 0.f;
    const size_t base = (size_t)b * SEQ * DM + c;
#pragma unroll 8
    for (int t = 0; t < SEQ; ++t) { const unsigned w = LAU[base + (size_t)t * DM]; const float la = bf2f(w & 0xffffu), u = bf2f(w >> 16);
        h = __expf(la) * h + u; const float y = bf2f(Y[base + (size_t)t * DM]); Y[base + (size_t)t * DM] = (bf16_t)f2bf(h * y); }
}

__global__ void __launch_bounds__(256) k_final_norm(Params p) {
    const int lane = threadIdx.x & 63; const int gw = blockIdx.x * 4 + (threadIdx.x >> 6), nw = gridDim.x * 4;
    const f32x4* g4 = (const f32x4*)p.in[I_FING] + lane;
    for (int m = gw; m < M; m += nw) { f32x4* xr = (f32x4*)(p.out + (size_t)m * DM) + lane; f32x4 v[4]; float s = 0.f;
#pragma unroll
        for (int j = 0; j < 4; ++j) { v[j] = xr[64 * j]; s += (v[j].x * v[j].x + v[j].y * v[j].y) + (v[j].z * v[j].z + v[j].w * v[j].w); }
        const float rs = rsqrtf(wave_sum(s) * (1.0f / DM) + NORM_EPS);
#pragma unroll
        for (int j = 0; j < 4; ++j) xr[64 * j] = v[j] * rs * g4[64 * j]; }
}


namespace pg8 {
#define PG8_LAS __attribute__((address_space(3)))
typedef short bf16x8 __attribute__((ext_vector_type(8)));
constexpr int BM = 256, BK = 64, HALF = 128, HTB = HALF * BK * 2  , STAGE_BYTES = 8 * HTB, NXCD = 8, WGM = 8;
__host__ __device__ __forceinline__ int lds_byte(int r, int c) { const int st = (r >> 4) * 2 + (c >> 5), rr = r & 15, cc = c & 31, ob = rr * 64 + cc * 2; return st * 1024 + (ob ^ (((ob >> 9) & 1) << 5)); }
__host__ __device__ __forceinline__ void stage_rc(int b, int& R, int& C) { const int st = b / 1024, sb = b % 1024, swz = sb ^ (((sb >> 9) & 1) << 5); R = (st >> 1) * 16 + swz / 64; C = (st & 1) * 32 + (swz % 64) / 2; }
__host__ __device__ __forceinline__ int perm32(int rho) { const int n = rho >> 4, i = rho & 15; return 8 * (i >> 2) + 4 * n + (i & 3); }
struct Unit { int pm, pn; };
struct Gemm { const bf16_t* A; const bf16_t* Bt; int M, N, K, lda, ldb, agrp; };
struct StaticOrder {
    int nM, nN, nwg, G, c;
    __host__ __device__ void init(int M, int N, int G_, int c_) { nM = M / BM; nN = N / BM; nwg = nM * nN; G = G_; c = c_; }
    __host__ __device__ bool next(int i, Unit& u) const {
        const long L = (long)i * G + c; if (L >= nwg) return false;
        int wgid = (int)L; { const int q = nwg / NXCD, r = nwg % NXCD, xcd = wgid % NXCD, off = wgid / NXCD; wgid = (xcd < r ? xcd * (q + 1) : r * (q + 1) + (xcd - r) * q) + off; }
        const int nig = WGM * nN, gid = wgid / nig, fm = gid * WGM, gsz = (nM - fm) < WGM ? (nM - fm) : WGM;
        u.pm = fm + ((wgid % nig) % gsz); u.pn = (wgid % nig) / gsz; return true;
    }
    __device__ __forceinline__ void a_ready(const Unit&) const {}
    __device__ __forceinline__ void done(const Unit&) const {}
};
template <class E8> struct EpiAdapt {
    static constexpr bool PERM = true, AFTER_DRAIN = false; E8 e;
    __device__ __forceinline__ void operator()(const f32x4 (&acc)[2][2][4][2], const Unit& u, int wr, int wc, int fr, int fq) const {
#pragma unroll
        for (int ai = 0; ai < 2; ++ai)
#pragma unroll
            for (int m = 0; m < 4; ++m) { const int row = u.pm * BM + ai * HALF + wr * 64 + m * 16 + fr; const typename E8::Ctx cx = e.row(row); float s = 0.f;
#pragma unroll
                for (int bj = 0; bj < 2; ++bj) s += e.apply(cx, row, u.pn * BM + bj * HALF + wc * 32 + 8 * fq, acc[ai][bj][m][0], acc[ai][bj][m][1]);
                if (E8::HAS_ROW_END) { s += __shfl_xor(s, 16); s += __shfl_xor(s, 32); if (fq == 0) e.row_end(row, s); } }
    }
};
template <class Epi, class Sched, bool ALIGN_EPI = false, bool SP2 = false>
__device__ __forceinline__ void gemm_phase(PG8_LAS unsigned char* lds, const Gemm g, const Sched& S, const Epi& E) {
    const int tid = threadIdx.x, wid = __builtin_amdgcn_readfirstlane(tid >> 6), lane = tid & 63, wr = wid >> 2, wc = wid & 3, fr = lane & 15, fq = lane >> 4;
    const int K = g.K, nt = K / BK;
    unsigned voffA[2], voffB[2];
#pragma unroll
    for (int i = 0; i < 2; ++i) { int R, C; stage_rc(tid * 16 + i * 8192, R, C); const int Rb = Epi::PERM ? ((R & ~31) + perm32(R & 31)) : R;
        voffA[i] = (unsigned)(R * g.lda + C) * 2u; voffB[i] = (unsigned)(Rb * g.ldb + C) * 2u; }
    const size_t kstep = (size_t)(BK * 2);
    const size_t hstepA = (size_t)HALF * g.lda * 2, hstepB = (size_t)HALF * g.ldb * 2;
    const size_t tstepA = 2 * hstepA, tstepB = 2 * hstepB;
#define PG8_ABASE(un) ((const char*)g.A + (size_t)(un).pm * tstepA + (g.agrp ? (size_t)((un).pn >> 1) * 512 : (size_t)0))
    const unsigned ldsw = (unsigned)wid * 1024u;
    const int aoff = lds_byte(wr * 64 + fr, fq * 8), boff = lds_byte(wc * 32 + fr, fq * 8);
#define PG8_SA(b, h) (((b) * 2 + (h)) * HTB)
#define PG8_SB(b, h) ((4 + (b) * 2 + (h)) * HTB)
#define PG8_STAGE(bufoff, gbase, voff) do { _Pragma("unroll") for (int _i = 0; _i < 2; ++_i) \
        __builtin_amdgcn_global_load_lds((const unsigned*)((const char*)(gbase) + (voff)[_i]), (PG8_LAS unsigned*)(lds + (bufoff) + ldsw + _i * 8192), 16, 0, 0); } while (0)
#define PG8_LDA(dst, b, h) do { _Pragma("unroll") for (int m = 0; m < 4; ++m) _Pragma("unroll") for (int k = 0; k < 2; ++k) dst[m][k] = *(const PG8_LAS bf16x8*)(lds + PG8_SA(b, h) + aoff + m * 2048 + k * 1024); } while (0)
#define PG8_LDB(dst, b, h) do { _Pragma("unroll") for (int n = 0; n < 2; ++n) _Pragma("unroll") for (int k = 0; k < 2; ++k) dst[n][k] = *(const PG8_LAS bf16x8*)(lds + PG8_SB(b, h) + boff + n * 2048 + k * 1024); } while (0)
#define PG8_MMA(ai, bj, At, Bt) do { __builtin_amdgcn_s_setprio(1); _Pragma("unroll") for (int m = 0; m < 4; ++m) _Pragma("unroll") for (int n = 0; n < 2; ++n) _Pragma("unroll") for (int k = 0; k < 2; ++k) \
        acc[ai][bj][m][n] = __builtin_amdgcn_mfma_f32_16x16x32_bf16(Bt[n][k], At[m][k], acc[ai][bj][m][n], 0, 0, 0); __builtin_amdgcn_s_setprio(0); } while (0)
#define PG8_WAIT_V(n) asm volatile("s_waitcnt vmcnt(" #n ")" ::: "memory")
#define PG8_WAIT_L(n) asm volatile("s_waitcnt lgkmcnt(" #n ")" ::: "memory")
#define PG8_BAR __builtin_amdgcn_s_barrier()
#define PG8_SCHED __builtin_amdgcn_sched_barrier(0)
    Unit cur, nxt; int ui = 0;
    if (!S.next(0, cur)) return;
    f32x4 acc[2][2][4][2];
#pragma unroll
    for (int a = 0; a < 2; ++a)
#pragma unroll
        for (int b = 0; b < 2; ++b)
#pragma unroll
            for (int m = 0; m < 4; ++m)
#pragma unroll
                for (int n = 0; n < 2; ++n) acc[a][b][m][n] = (f32x4){0.f, 0.f, 0.f, 0.f};
    bf16x8 At[4][2], B0[2][2], B1[2][2];
    const char* cA = PG8_ABASE(cur); const char* cB = (const char*)g.Bt + (size_t)cur.pn * tstepB;
    S.a_ready(cur);
    if constexpr (SP2) {
        PG8_STAGE(PG8_SB(0, 0), cB, voffB); PG8_STAGE(PG8_SB(0, 1), cB + hstepB, voffB); PG8_STAGE(PG8_SA(0, 0), cA, voffA); PG8_STAGE(PG8_SA(0, 1), cA + hstepA, voffA);
        if (wr == 1) PG8_BAR;
        PG8_WAIT_V(2); PG8_BAR;
        PG8_STAGE(PG8_SB(1, 0), cB + kstep, voffB); PG8_STAGE(PG8_SA(1, 0), cA + kstep, voffA); PG8_STAGE(PG8_SB(1, 1), cB + hstepB + kstep, voffB);
        PG8_WAIT_V(6); PG8_BAR;
    } else {
        PG8_STAGE(PG8_SB(0, 0), cB, voffB); PG8_STAGE(PG8_SA(0, 0), cA, voffA); PG8_STAGE(PG8_SB(0, 1), cB + hstepB, voffB); PG8_STAGE(PG8_SA(0, 1), cA + hstepA, voffA);
        if (wr == 1) PG8_BAR;
        PG8_WAIT_V(4); PG8_BAR;
        PG8_STAGE(PG8_SB(1, 0), cB + kstep, voffB); PG8_STAGE(PG8_SA(1, 0), cA + kstep, voffA); PG8_STAGE(PG8_SB(1, 1), cB + hstepB + kstep, voffB);
        PG8_WAIT_V(6); PG8_BAR;
    }
    for (;;) {
        const bool has_next = S.next(ui + 1, nxt);
        const char* nA = has_next ? PG8_ABASE(nxt) : cA; const char* nB = has_next ? (const char*)g.Bt + (size_t)nxt.pn * tstepB : cB;
        for (int t = 0; t < nt; t += 2) {
            const bool last = (t == nt - 2);
            const char* a1 = cA + (size_t)(t + 1) * kstep;
            const char* a2 = last ? nA : cA + (size_t)(t + 2) * kstep; const char* b2 = last ? nB : cB + (size_t)(t + 2) * kstep;
            const char* a3 = a2 + kstep; const char* b3 = b2 + kstep;
            if (last && has_next) S.a_ready(nxt);
            if constexpr (SP2) {
            PG8_LDB(B0, 0, 0); PG8_LDB(B1, 0, 1); PG8_SCHED; PG8_LDA(At, 0, 0); PG8_STAGE(PG8_SA(1, 1), a1 + hstepA, voffA);
            PG8_WAIT_V(8); PG8_WAIT_L(0); PG8_BAR; PG8_MMA(0, 0, At, B0); PG8_MMA(0, 1, At, B1); PG8_BAR; PG8_SCHED;
            PG8_LDA(At, 0, 1); PG8_STAGE(PG8_SB(0, 0), b2, voffB); PG8_STAGE(PG8_SB(0, 1), b2 + hstepB, voffB); PG8_STAGE(PG8_SA(0, 0), a2, voffA);
            PG8_WAIT_V(8); PG8_WAIT_L(0); PG8_BAR; PG8_MMA(1, 0, At, B0); PG8_MMA(1, 1, At, B1); PG8_BAR; PG8_SCHED;
            PG8_LDB(B0, 1, 0); PG8_LDB(B1, 1, 1); PG8_SCHED; PG8_LDA(At, 1, 0); PG8_STAGE(PG8_SA(0, 1), a2 + hstepA, voffA);
            PG8_WAIT_V(8); PG8_WAIT_L(0); PG8_BAR; PG8_MMA(0, 0, At, B0); PG8_MMA(0, 1, At, B1); PG8_BAR; PG8_SCHED;
            PG8_LDA(At, 1, 1); PG8_STAGE(PG8_SB(1, 0), b3, voffB); PG8_STAGE(PG8_SB(1, 1), b3 + hstepB, voffB); PG8_STAGE(PG8_SA(1, 0), a3, voffA);
            PG8_WAIT_V(8); PG8_WAIT_L(0); PG8_BAR; PG8_MMA(1, 0, At, B0); PG8_MMA(1, 1, At, B1); PG8_BAR; PG8_SCHED;
            } else {
            PG8_LDB(B0, 0, 0); PG8_SCHED; PG8_LDA(At, 0, 0); PG8_STAGE(PG8_SA(1, 1), a1 + hstepA, voffA);
            PG8_WAIT_L(8); PG8_BAR; PG8_WAIT_L(0); PG8_MMA(0, 0, At, B0); PG8_BAR; PG8_SCHED;
            PG8_LDB(B1, 0, 1); PG8_STAGE(PG8_SB(0, 0), b2, voffB);
            PG8_BAR; PG8_WAIT_L(0); PG8_MMA(0, 1, At, B1); PG8_BAR;
            PG8_LDA(At, 0, 1); PG8_STAGE(PG8_SA(0, 0), a2, voffA);
            PG8_BAR; PG8_WAIT_L(0); PG8_MMA(1, 0, At, B0); PG8_BAR; PG8_SCHED;
            PG8_STAGE(PG8_SB(0, 1), b2 + hstepB, voffB);
            PG8_WAIT_V(6); PG8_BAR; PG8_MMA(1, 1, At, B1); PG8_BAR;
            PG8_LDB(B0, 1, 0); PG8_SCHED; PG8_LDA(At, 1, 0); PG8_STAGE(PG8_SA(0, 1), a2 + hstepA, voffA);
            PG8_WAIT_L(8); PG8_BAR; PG8_WAIT_L(0); PG8_MMA(0, 0, At, B0); PG8_BAR; PG8_SCHED;
            PG8_LDB(B1, 1, 1); PG8_STAGE(PG8_SB(1, 0), b3, voffB);
            PG8_BAR; PG8_WAIT_L(0); PG8_MMA(0, 1, At, B1); PG8_BAR;
            PG8_LDA(At, 1, 1); PG8_STAGE(PG8_SA(1, 0), a3, voffA);
            PG8_BAR; PG8_WAIT_L(0); PG8_MMA(1, 0, At, B0); PG8_BAR; PG8_SCHED;
            PG8_STAGE(PG8_SB(1, 1), b3 + hstepB, voffB);
            PG8_WAIT_V(6); PG8_BAR; PG8_MMA(1, 1, At, B1); PG8_BAR;
            }
        }
        if constexpr (ALIGN_EPI) { if (wr == 0) PG8_BAR; }
        if constexpr (!Epi::AFTER_DRAIN) { E(acc, cur, wr, wc, fr, fq); S.done(cur); }
        if (!has_next) break;
#pragma unroll
        for (int a = 0; a < 2; ++a)
#pragma unroll
            for (int b = 0; b < 2; ++b)
#pragma unroll
                for (int m = 0; m < 4; ++m)
#pragma unroll
                    for (int n = 0; n < 2; ++n) acc[a][b][m][n] = (f32x4){0.f, 0.f, 0.f, 0.f};
        cur = nxt; cA = nA; cB = nB; ++ui;
        if constexpr (ALIGN_EPI) { if (wr == 1) PG8_BAR; }
    }
    PG8_WAIT_V(0);
    if constexpr (!ALIGN_EPI) { if (wr == 0) PG8_BAR; }
    PG8_BAR;
    if constexpr (Epi::AFTER_DRAIN) { E.fused(acc, cur, wr, wc, fr, fq, lds, wid, lane); S.done(cur); }
#undef PG8_SA
#undef PG8_SB
#undef PG8_STAGE
#undef PG8_LDA
#undef PG8_LDB
#undef PG8_MMA
#undef PG8_WAIT_V
#undef PG8_WAIT_L
#undef PG8_BAR
#undef PG8_SCHED
#undef PG8_ABASE
}
}

constexpr int NWAVES = 8;
constexpr int RING_BYTES = 131072, LDSCTL_OFF = RING_BYTES, MISC_OFF = LDSCTL_OFF + 320, LDS_BYTES = 147456;
constexpr int CW_BAR = 4096;
constexpr int NPH = 14;
#define GAS __attribute__((address_space(1)))
typedef GAS unsigned gu32;
#define RLX_AGENT __ATOMIC_RELAXED, __HIP_MEMORY_SCOPE_AGENT
#define XB_TMO      128
#define XB_XCNT(j)  (256  + 64 * (j))
#define XB_XSUB(j)  (1280 + 64 * (j))
#define XB_XGEN(j)  (2304 + 64 * (j))
#define XB_TOP      3328
#define XB_TOPGEN   3392
#define XCD_BAR_WORDS 3456
#define XB_SPIN_CAP (1u << 18)

__device__ __forceinline__ unsigned xb_ld(unsigned* p)              { return __hip_atomic_load(p, __ATOMIC_RELAXED, __HIP_MEMORY_SCOPE_AGENT); }
__device__ __forceinline__ unsigned xb_add(unsigned* p, unsigned v) { return __hip_atomic_fetch_add(p, v, __ATOMIC_RELAXED, __HIP_MEMORY_SCOPE_AGENT); }
__device__ __forceinline__ unsigned xb_xcc_id() { return (unsigned)__builtin_amdgcn_s_getreg((3 << 11) | 20) & 0xFu; }
#define XB_SPIN(cond, bar) do { unsigned _sp = 0; while (cond) { __builtin_amdgcn_s_sleep(1); \
    if ((++_sp & 255u) == 0u) { if (xb_ld(&(bar)[XB_TMO])) break; if (_sp > XB_SPIN_CAP) { atomicAdd(&(bar)[XB_TMO], 1u); break; } } } } while (0)

struct XcdBarrier {
    unsigned* bar; unsigned x;
    volatile LAS unsigned* st;
};

__device__ __forceinline__ XcdBarrier xcd_barrier_post(unsigned* bar, volatile LAS unsigned* st) {
    XcdBarrier b; b.bar = bar; b.x = xb_xcc_id(); b.st = st;
    if (threadIdx.x == 0) (void)xb_add(&bar[XB_XCNT(b.x)], 1u);
    return b;
}
__device__ __forceinline__ void xcd_barrier_complete(unsigned* bar, unsigned x, unsigned& nloc, unsigned& nx) {
    const unsigned G = gridDim.x * gridDim.y * gridDim.z;
    unsigned sum, cnt, mine, sp = 0u;
    for (;;) {
        sum = 0u; cnt = 0u; mine = 0u;
#pragma unroll
        for (unsigned j = 0; j < 16; ++j) { const unsigned c = xb_ld(&bar[XB_XCNT(j)]); sum += c; cnt += (c > 0u) ? 1u : 0u; mine = (j == x) ? c : mine; }
        if (sum == G) break;
        __builtin_amdgcn_s_sleep(1);
        if ((++sp & 255u) == 0u) { if (xb_ld(&bar[XB_TMO])) break; if (sp > XB_SPIN_CAP) { atomicAdd(&bar[XB_TMO], 1u); break; } }
    }
    nloc = mine > 0u ? mine : 1u; nx = cnt > 0u ? cnt : 1u;
}

__device__ __forceinline__ void xcd_barrier(const XcdBarrier& b) {
    asm volatile("s_waitcnt vmcnt(0)" ::: "memory");
    __syncthreads();
    if (threadIdx.x == 0) {
        unsigned* bar = b.bar;
        __builtin_amdgcn_s_waitcnt(0);
        unsigned nloc = b.st[0], nx = b.st[1];
        if (nloc == 0u) { xcd_barrier_complete(bar, b.x, nloc, nx); b.st[0] = nloc; b.st[1] = nx; }
        const unsigned old = xb_add(&bar[XB_XSUB(b.x)], 1u);
        const unsigned gen = old / nloc;
        if (old + 1u == (gen + 1u) * nloc) {
            __builtin_amdgcn_fence(__ATOMIC_RELEASE, "agent");
            asm volatile("s_waitcnt vmcnt(0)" ::: "memory");
            const unsigned og = xb_add(&bar[XB_TOP], 1u);
            const unsigned tg = og / nx;
            if (og + 1u == (tg + 1u) * nx) xb_add(&bar[XB_TOPGEN], 1u);
            else XB_SPIN(xb_ld(&bar[XB_TOPGEN]) == tg, bar);
            __builtin_amdgcn_fence(__ATOMIC_ACQUIRE, "agent");
            xb_add(&bar[XB_XGEN(b.x)], 1u);
            asm volatile("s_waitcnt vmcnt(0)" ::: "memory");
        } else {
            XB_SPIN(xb_ld(&bar[XB_XGEN(b.x)]) == gen, bar);
            __builtin_amdgcn_fence(__ATOMIC_ACQUIRE, "agent");
            asm volatile("s_waitcnt vmcnt(0)" ::: "memory");
        }
    }
    __syncthreads();
}

struct Args { Params p; int ph_lo, ph_hi, li, pad; };
__global__ void __launch_bounds__(NWAVES * 64, 2) mega(Args a) {
    extern __shared__ __attribute__((aligned(16))) unsigned char lds_raw[];
    LAS unsigned char* lds = (LAS unsigned char*)lds_raw;
    volatile LAS unsigned* MISC = (volatile LAS unsigned*)(lds + MISC_OFF);
    const int tid = threadIdx.x, lane = tid & 63, wave = __builtin_amdgcn_readfirstlane(tid >> 6);
    const int G = gridDim.x; const int bx = blockIdx.x; const int vcu = (G % 8 == 0) ? (bx % 8) * (G / 8) + bx / 8 : bx;
    unsigned char* ws = a.p.ws;
    for (int u = tid; u < (LDS_BYTES - LDSCTL_OFF) / 4; u += NWAVES * 64) ((LAS unsigned*)(lds + LDSCTL_OFF))[u] = 0u;
    __syncthreads();
    XcdBarrier bar = xcd_barrier_post((unsigned*)(ws + WS_CTL) + CW_BAR + a.li * XCD_BAR_WORDS, MISC + 8);
    const int lo = a.ph_lo, hi = a.ph_hi;
#define IN(k) (lo <= (k) && (k) < hi)
#define SEAM(k) do { if (IN(k) && IN((k) + 1)) xcd_barrier(bar); } while (0)
    float* ssq = (float*)(ws + WS_SSQ); float* par = (float*)(ws + WS_PAR);
    const float* cosT = (const float*)(ws + WS_ROPE); const float* sinT = cosT + 4096 * 32;
    bf16_t* XB = (bf16_t*)(ws + WS_XB);
#define GEMM_PHASE(ET, EOBJ, AP, LDA, BP, LDB, NN, KK, AGRP) do { pg8::Gemm g{(const bf16_t*)(AP), (const bf16_t*)(BP), M, NN, KK, LDA, LDB, AGRP}; pg8::StaticOrder S; S.init(M, NN, G, bx); \
        pg8::EpiAdapt<ET> E{EOBJ}; pg8::gemm_phase<pg8::EpiAdapt<ET>, pg8::StaticOrder, true, true>(lds, g, S, E); } while (0)
    if (IN(0)) { prologue_work(a.p, vcu * NWAVES + wave, G * NWAVES, lane, (LAS float*)(lds + wave * 16384)); SEAM(0); }
    if (IN(1)) { GEMM_PHASE(EpiQKV, (EpiQKV{ssq, cosT, sinT, (bf16_t*)(ws + WS_Q)}), XB, DM, ws + WS_WQKV, DM, 3072, DM, 0); SEAM(1); }
    if (IN(2)) { SEAM(2); }
    if (IN(3)) { GEMM_PHASE(EpiRes, (EpiRes{a.p.in[I_X], a.p.out, XB, ssq + M}), ws + WS_Q, DM, ws + WS_WO, DM, DM, DM, 0); SEAM(3); }
    if (IN(4)) { GEMM_PHASE(EpiUp, (EpiUp{ssq + M, (bf16_t*)(ws + WS_H)}), XB, DM, ws + WS_W1, DM, FF, DM, 0); SEAM(4); }
    if (IN(5)) { GEMM_PHASE(EpiRes, (EpiRes{a.p.out, a.p.out, XB, ssq + 2 * M}), ws + WS_H, FF, ws + WS_W2, FF, DM, FF, 0); SEAM(5); }
    if (IN(6)) { GEMM_PHASE(EpiRecIn, (EpiRecIn{ssq + 2 * M, (bf16_t*)(ws + WS_Y), (bf16_t*)(ws + WS_XP)}), XB, DM, ws + WS_WYX, DM, 2048, DM, 0); SEAM(6); }
    if (IN(7)) { SEAM(7); }
    if (IN(8)) { GEMM_PHASE(EpiGates, (EpiGates{a.p.in[I_RBA], a.p.in[I_RBI], par + 256, (const bf16_t*)(ws + WS_XC), (bf16_t*)(ws + WS_LAU)}), ws + WS_XC, DM, ws + WS_WG, 256, 2048, 256, 1); SEAM(8); }
    if (IN(9)) { SEAM(9); }
    if (IN(10)) { GEMM_PHASE(EpiRes, (EpiRes{a.p.out, a.p.out, XB, ssq + 3 * M}), ws + WS_Y, DM, ws + WS_WRO, DM, DM, DM, 0); SEAM(10); }
    if (IN(11)) { GEMM_PHASE(EpiUp, (EpiUp{ssq + 3 * M, (bf16_t*)(ws + WS_H)}), XB, DM, ws + WS_W1 + 8 * MiB, DM, FF, DM, 0); SEAM(11); }
    if (IN(12)) { GEMM_PHASE(EpiRes, (EpiRes{a.p.out, a.p.out, nullptr, nullptr}), ws + WS_H, FF, ws + WS_W2 + 8 * MiB, FF, DM, FF, 0); SEAM(12); }
    if (IN(13)) { }
#undef IN
#undef SEAM
#undef GEMM_PHASE
}

constexpr unsigned NAIVE_MASK = (1u << 2) | (1u << 7) | (1u << 9) | (1u << 13);
extern "C" void kernel_launch(void* const* d_in, const int* in_sizes, int n_in, void* d_out, int out_size, void* d_ws, size_t ws_size, hipStream_t stream) {
    static int grid = 0;
    if (grid == 0) {
        if (n_in != 23 || in_sizes[0] != M * DM || out_size != M * DM || ws_size < WS_END) { fprintf(stderr, "kernel_launch: unexpected shapes (n_in %d, in0 %d, out %d, ws %zu)\n", n_in, n_in > 0 ? in_sizes[0] : -1, out_size, ws_size); grid = -1; return; }
        if (hipFuncSetAttribute((const void*)k_attn_naive, hipFuncAttributeMaxDynamicSharedMemorySize, ATN_LDS) != hipSuccess) { fprintf(stderr, "kernel_launch: hipFuncSetAttribute failed\n"); grid = -1; return; }
        if (hipFuncSetAttribute((const void*)mega, hipFuncAttributeMaxDynamicSharedMemorySize, LDS_BYTES) != hipSuccess) { fprintf(stderr, "kernel_launch: hipFuncSetAttribute(mega) failed\n"); grid = -1; return; }
        int dev = 0, cus = 0, per_cu = 0;
        if (hipGetDevice(&dev) != hipSuccess || hipDeviceGetAttribute(&cus, hipDeviceAttributeMultiprocessorCount, dev) != hipSuccess) { grid = -1; return; }
        if (hipOccupancyMaxActiveBlocksPerMultiprocessor(&per_cu, (const void*)mega, NWAVES * 64, LDS_BYTES) != hipSuccess || per_cu < 1) { fprintf(stderr, "kernel_launch: occupancy query says %d blocks per CU\n", per_cu); grid = -1; (void)hipGetLastError(); return; }
        grid = cus;
        if (grid != 256) fprintf(stderr, "kernel_launch: note: %d CUs\n", grid);
    }
    if (grid < 0) return;
    Args a{};
    for (int i = 0; i < 23; ++i) a.p.in[i] = (const float*)d_in[i];
    a.p.out = (float*)d_out; a.p.ws = (unsigned char*)d_ws;
    (void)hipMemsetAsync((unsigned char*)d_ws + WS_CTL, 0, CTL_ZERO_BYTES, stream);
    int li = 0;
    for (int ph = 0; ph < NPH;) {
        if (NAIVE_MASK & (1u << ph)) {
            if (ph == 2) k_attn_naive<<<4096, 256, ATN_LDS, stream>>>(a.p);
            else if (ph == 7) k_conv<<<2048, 256, 0, stream>>>(a.p);
            else if (ph == 9) k_scan_naive<<<BATCH * DM / 256, 256, 0, stream>>>(a.p);
            else if (ph == 13) k_final_norm<<<2048, 256, 0, stream>>>(a.p);
            ++ph; continue;
        }
        int e = ph; while (e < NPH && !(NAIVE_MASK & (1u << e))) ++e;
        a.ph_lo = ph; a.ph_hi = e; a.li = li++;
        hipLaunchKernelGGL(mega, dim3(grid), dim3(NWAVES * 64), LDS_BYTES, stream, a);
        ph = e;
    }
}
```

```cpp
#include <hip/hip_runtime.h>
#include <stdint.h>
#include <cstdio>

#define LAS __attribute__((address_space(3)))
typedef unsigned short bf16_t;
typedef float f32x4 __attribute__((ext_vector_type(4)));
typedef unsigned u32x4 __attribute__((ext_vector_type(4)));
typedef unsigned u32x2 __attribute__((ext_vector_type(2)));

constexpr int BATCH = 8, SEQ = 4096, DM = 1024, FF = 4096, M = BATCH * SEQ;
constexpr int NH = 8;
constexpr float NORM_EPS = 1e-6f, SUBLN_EPS = 1e-5f;
constexpr float LAMBDA_INIT = 0.2f;
constexpr float C2 = 0.18033688011112042f;

constexpr size_t MiB = 1u << 20;
constexpr size_t WS_CTL = 0, CTL_ZERO_BYTES = 2 * MiB;
constexpr size_t WS_SSQ = 1 * MiB;
constexpr size_t WS_PAR = 2 * MiB;
constexpr size_t WS_ROPE = 3 * MiB;
constexpr size_t WS_WQKV = 4 * MiB, WS_WO = 10 * MiB, WS_W1 = 12 * MiB  , WS_W2 = 28 * MiB  , WS_WYX = 44 * MiB, WS_WG = 48 * MiB, WS_WRO = 49 * MiB;
constexpr size_t WS_XB = 52 * MiB;
constexpr size_t WS_R = 116 * MiB;
constexpr size_t WS_Q = WS_R, WS_K = WS_R + 64 * MiB, WS_V = WS_R + 128 * MiB, WS_H = WS_R;
constexpr size_t WS_Y = WS_R, WS_XC = WS_R + 64 * MiB, WS_XP = WS_R + 128 * MiB, WS_LAU = WS_R + 128 * MiB;
constexpr size_t WS_END = WS_R + 256 * MiB;

struct Params { const float* in[23]; float* out; unsigned char* ws; };

enum { I_X = 0, I_MIXG, I_MLPG, I_WQKV, I_WO, I_LQ1, I_LK1, I_LQ2, I_LK2, I_SUBG, I_RWX, I_RWY, I_CONVW, I_CONVB, I_RWA, I_RBA, I_RWI, I_RBI, I_RLAM, I_RWO, I_W1, I_W2, I_FING };

__device__ __forceinline__ float bf2f(unsigned b) { return __uint_as_float(b << 16); }
__device__ __forceinline__ unsigned f2bf(float f) { unsigned u = __float_as_uint(f); return (u + 0x7fffu + ((u >> 16) & 1u)) >> 16; }
__device__ __forceinline__ unsigned pk2(float lo, float hi) { return f2bf(lo) | (f2bf(hi) << 16); }
__device__ __forceinline__ u32x4 pk8(f32x4 a, f32x4 b) { u32x4 w; w.x = pk2(a[0], a[1]); w.y = pk2(a[2], a[3]); w.z = pk2(b[0], b[1]); w.w = pk2(b[2], b[3]); return w; }
__device__ __forceinline__ void unpk8(u32x4 w, float* f) { f[0] = bf2f(w.x & 0xffffu); f[1] = bf2f(w.x >> 16); f[2] = bf2f(w.y & 0xffffu); f[3] = bf2f(w.y >> 16);
    f[4] = bf2f(w.z & 0xffffu); f[5] = bf2f(w.z >> 16); f[6] = bf2f(w.w & 0xffffu); f[7] = bf2f(w.w >> 16); }
__device__ __forceinline__ float wave_sum(float v) {
#pragma unroll
    for (int o = 1; o < 64; o <<= 1) v += __shfl_xor(v, o);
    return v;
}
__device__ __forceinline__ float sigmoidf_(float x) { return 1.0f / (1.0f + __expf(-x)); }
__device__ __forceinline__ float gelu_tanh(float x) { const float z = 0.7978845608028654f * (x + 0.044715f * x * x * x); return x / (1.0f + __expf(-2.0f * z)); }

__device__ __forceinline__ int rope_phys(int d) { return d < 32 ? 8 * (d >> 2) + (d & 3) : 8 * ((d - 32) >> 2) + 4 + (d & 3); }

__device__ const double INV_FREQ[32] = {1.0, 0.7498942093324559, 0.5623413251903491, 0.4216965034285822, 0.31622776601683794, 0.23713737056616552, 0.1778279410038923, 0.1333521432163324, 0.1,
    0.07498942093324558, 0.05623413251903491, 0.042169650342858224, 0.03162277660168379, 0.023713737056616554, 0.01778279410038923, 0.01333521432163324, 0.01, 0.007498942093324558,
    0.005623413251903491, 0.004216965034285823, 0.0031622776601683794, 0.0023713737056616554, 0.0017782794100389228, 0.001333521432163324, 0.001, 0.0007498942093324559,
    0.0005623413251903491, 0.00042169650342858224, 0.00031622776601683794, 0.00023713737056616554, 0.00017782794100389227, 0.0001333521432163324};

__device__ __forceinline__ void sincos_d(double ang, float& s, float& c) {
    const double k = __builtin_rint(ang * 0.6366197723675814);
    const double r = ang - k * 1.5707963267948966;
    const double r2 = r * r;
    double sp = -1.0 / 1307674368000.0; sp = sp * r2 + 1.0 / 6227020800.0; sp = sp * r2 - 1.0 / 39916800.0; sp = sp * r2 + 1.0 / 362880.0; sp = sp * r2 - 1.0 / 5040.0; sp = sp * r2 + 1.0 / 120.0; sp = sp * r2 - 1.0 / 6.0; sp = sp * r2 + 1.0;
    const double sn = sp * r;
    double cp = 1.0 / 87178291200.0; cp = cp * r2 - 1.0 / 479001600.0; cp = cp * r2 + 1.0 / 3628800.0; cp = cp * r2 - 1.0 / 40320.0; cp = cp * r2 + 1.0 / 720.0; cp = cp * r2 - 1.0 / 24.0; cp = cp * r2 + 0.5; const double cs = 1.0 - cp * r2;
    const int q = ((int)k) & 3;
    const double ss = (q == 0) ? sn : (q == 1) ? cs : (q == 2) ? -sn : -cs;
    const double cc = (q == 0) ? cs : (q == 1) ? -sn : (q == 2) ? -cs : sn;
    s = (float)ss; c = (float)cc;
}

template <class RowMap>
__device__ __forceinline__ void tr_item(const float* W, int N, int K, bf16_t* WT, const float* g, LAS float* scr, int item, int lane, RowMap rm) {
    const int nblk = N / 32, kb = item / nblk, nb = item % nblk, k0 = 64 * kb, n0 = 32 * nb;
#pragma unroll 8
    for (int i = 0; i < 32; ++i) { const int kk = 2 * i + (lane >> 5); float v = W[(size_t)(k0 + kk) * N + n0 + (lane & 31)]; if (g) v *= g[k0 + kk]; scr[kk * 33 + (lane & 31)] = v; }
    asm volatile("s_waitcnt lgkmcnt(0)" ::: "memory");
    const int c = lane & 7;
#pragma unroll
    for (int j = 0; j < 4; ++j) { const int n = (lane >> 3) + 8 * j; const LAS float* s = scr + (8 * c) * 33 + n;
        u32x4 o; o.x = pk2(s[0 * 33], s[1 * 33]); o.y = pk2(s[2 * 33], s[3 * 33]); o.z = pk2(s[4 * 33], s[5 * 33]); o.w = pk2(s[6 * 33], s[7 * 33]);
        *(u32x4*)(WT + (size_t)rm(n0 + n) * K + k0 + 8 * c) = o; }
    asm volatile("s_waitcnt lgkmcnt(0)" ::: "memory");
}
struct MapId { int base; __device__ __forceinline__ int operator()(int n) const { return base + n; } };
struct MapQKV { __device__ __forceinline__ int operator()(int n) const { return n < 2048 ? (n & ~63) + rope_phys(n & 63) : n; } };
struct MapGate { int base; __device__ __forceinline__ int operator()(int d) const { return base + 8 * (d >> 2) + (d & 3); } };

__device__ __forceinline__ void prologue_work(const Params& p, int gw, int nw, int lane, LAS float* scr) {
    unsigned char* ws = p.ws;
    constexpr int IT_QKV = 16 * 96, IT_SQ = 16 * 32, IT_W1 = 16 * 128, IT_W2 = 64 * 32, IT_G = 4 * 8;
    constexpr int NIT = IT_QKV + IT_SQ + 2 * IT_W1 + 2 * IT_W2 + 2 * IT_SQ + 8 * IT_G + IT_SQ;
    for (int it = gw; it < NIT; it += nw) {
        int r = it;
        if (r < IT_QKV) { tr_item(p.in[I_WQKV], 3072, 1024, (bf16_t*)(ws + WS_WQKV), p.in[I_MIXG], scr, r, lane, MapQKV{}); continue; } r -= IT_QKV;
        if (r < IT_SQ) { tr_item(p.in[I_WO], 1024, 1024, (bf16_t*)(ws + WS_WO), nullptr, scr, r, lane, MapId{0}); continue; } r -= IT_SQ;
        if (r < 2 * IT_W1) { const int l = r / IT_W1; tr_item(p.in[I_W1] + (size_t)l * 1024 * 4096, 4096, 1024, (bf16_t*)(ws + WS_W1 + l * 8 * MiB), p.in[I_MLPG] + l * 1024, scr, r % IT_W1, lane, MapId{0}); continue; } r -= 2 * IT_W1;
        if (r < 2 * IT_W2) { const int l = r / IT_W2; tr_item(p.in[I_W2] + (size_t)l * 1024 * 4096, 1024, 4096, (bf16_t*)(ws + WS_W2 + l * 8 * MiB), nullptr, scr, r % IT_W2, lane, MapId{0}); continue; } r -= 2 * IT_W2;
        if (r < IT_SQ) { tr_item(p.in[I_RWY], 1024, 1024, (bf16_t*)(ws + WS_WYX), p.in[I_MIXG] + 1024, scr, r, lane, MapId{0}); continue; } r -= IT_SQ;
        if (r < IT_SQ) { tr_item(p.in[I_RWX], 1024, 1024, (bf16_t*)(ws + WS_WYX), p.in[I_MIXG] + 1024, scr, r, lane, MapId{1024}); continue; } r -= IT_SQ;
        if (r < 8 * IT_G) { const int w = r / IT_G, grp = w & 3, isi = w >> 2;
            tr_item(p.in[isi ? I_RWI : I_RWA] + (size_t)grp * 65536, 256, 256, (bf16_t*)(ws + WS_WG), nullptr, scr, r % IT_G, lane, MapGate{grp * 512 + isi * 4}); continue; } r -= 8 * IT_G;
        tr_item(p.in[I_RWO], 1024, 1024, (bf16_t*)(ws + WS_WRO), nullptr, scr, r, lane, MapId{0});
    }
    float* par = (float*)(ws + WS_PAR);
    float* cosT = (float*)(ws + WS_ROPE); float* sinT = cosT + 4096 * 32;
    for (int e = gw * 64 + lane; e < 4096 * 32; e += nw * 64) { const int pos = e >> 5, i = e & 31; float s, c; sincos_d((double)pos * INV_FREQ[i], s, c); cosT[e] = c; sinT[e] = s; }
    for (int c = gw * 64 + lane; c < 1024; c += nw * 64) {
        const float x = -p.in[I_RLAM][c]; const float z = __expf(-fabsf(x));
        const float l1p = (z < 0.02f) ? z * (1.0f + z * (-0.5f + z * (0.33333333f + z * (-0.25f + z * 0.2f)))) : __logf(1.0f + z);
        par[256 + c] = 8.0f * (fmaxf(x, 0.f) + l1p);
    }
    if (gw == 0) { float a = p.in[I_LQ1][lane] * p.in[I_LK1][lane], b = p.in[I_LQ2][lane] * p.in[I_LK2][lane]; a = wave_sum(a); b = wave_sum(b);
        if (lane == 0) par[0] = expf(a) - expf(b) + LAMBDA_INIT; }
    bf16_t* XB = (bf16_t*)(ws + WS_XB); float* ssq0 = (float*)(ws + WS_SSQ);
    for (int m = gw; m < M; m += nw) {
        const f32x4* xr = (const f32x4*)(p.in[I_X] + (size_t)m * DM) + lane; float s = 0.f;
        u32x2* o8 = (u32x2*)(XB + (size_t)m * DM) + lane;
#pragma unroll
        for (int j = 0; j < 4; ++j) { const f32x4 v = xr[64 * j]; s += (v.x * v.x + v.y * v.y) + (v.z * v.z + v.w * v.w); u32x2 w; w.x = pk2(v.x, v.y); w.y = pk2(v.z, v.w); o8[64 * j] = w; }
        s = wave_sum(s); if (lane == 0) ssq0[m] = s;
    }
}

struct EpiQKV {
    const float* ssq; const float* cosT; const float* sinT; bf16_t* Q;
    struct Ctx { float rs; int pos; };
    __device__ __forceinline__ Ctx row(int r) const { Ctx c; c.rs = rsqrtf(ssq[r] * (1.0f / DM) + NORM_EPS); c.pos = r & (SEQ - 1); return c; }
    __device__ __forceinline__ float apply(const Ctx& c, int r, int c0, f32x4 lo, f32x4 hi) const {
        lo = lo * c.rs; hi = hi * c.rs;
        const int sec = c0 >> 10, cc = c0 & 1023;
        if (sec < 2) { const int g = (c0 & 63) >> 3; const f32x4 cs = *(const f32x4*)(cosT + c.pos * 32 + 4 * g), sn = *(const f32x4*)(sinT + c.pos * 32 + 4 * g);
            f32x4 nlo = lo * cs - hi * sn, nhi = hi * cs + lo * sn; if (sec == 0) { nlo = nlo * C2; nhi = nhi * C2; } lo = nlo; hi = nhi; }
        *(u32x4*)(Q + (size_t)sec * ((size_t)M * DM) + (size_t)r * DM + cc) = pk8(lo, hi);
        return 0.f;
    }
    __device__ __forceinline__ void row_end(int, float) const {}
    static constexpr bool HAS_ROW_END = false;
};
struct EpiRes {
    const float* xin; float* xout; bf16_t* XB; float* ssq;
    struct Ctx { int dummy; };
    __device__ __forceinline__ Ctx row(int) const { return Ctx{0}; }
    __device__ __forceinline__ float apply(const Ctx&, int r, int c0, f32x4 lo, f32x4 hi) const {
        const size_t off = (size_t)r * DM + c0;
        const f32x4 a = *(const f32x4*)(xin + off) + lo, b = *(const f32x4*)(xin + off + 4) + hi;
        *(f32x4*)(xout + off) = a; *(f32x4*)(xout + off + 4) = b;
        if (XB) *(u32x4*)(XB + off) = pk8(a, b);
        return (a[0] * a[0] + a[1] * a[1]) + (a[2] * a[2] + a[3] * a[3]) + (b[0] * b[0] + b[1] * b[1]) + (b[2] * b[2] + b[3] * b[3]);
    }
    __device__ __forceinline__ void row_end(int r, float s) const { if (ssq) atomicAdd(ssq + r, s); }
    static constexpr bool HAS_ROW_END = true;
};
struct EpiUp {
    const float* ssq; bf16_t* H;
    struct Ctx { float rs; };
    __device__ __forceinline__ Ctx row(int r) const { return Ctx{rsqrtf(ssq[r] * (1.0f / DM) + NORM_EPS)}; }
    __device__ __forceinline__ float apply(const Ctx& c, int r, int c0, f32x4 lo, f32x4 hi) const {
        lo = lo * c.rs; hi = hi * c.rs;
#pragma unroll
        for (int j = 0; j < 4; ++j) { const float a = fmaxf(lo[j], 0.f), b = fmaxf(hi[j], 0.f); lo[j] = a * a; hi[j] = b * b; }
        *(u32x4*)(H + (size_t)r * FF + c0) = pk8(lo, hi); return 0.f;
    }
    __device__ __forceinline__ void row_end(int, float) const {}
    static constexpr bool HAS_ROW_END = false;
};
struct EpiRecIn {
    const float* ssq; bf16_t* Y; bf16_t* XP;
    struct Ctx { float rs; };
    __device__ __forceinline__ Ctx row(int r) const { return Ctx{rsqrtf(ssq[r] * (1.0f / DM) + NORM_EPS)}; }
    __device__ __forceinline__ float apply(const Ctx& c, int r, int c0, f32x4 lo, f32x4 hi) const {
        lo = lo * c.rs; hi = hi * c.rs;
        if (c0 < 1024) {
#pragma unroll
            for (int j = 0; j < 4; ++j) { lo[j] = gelu_tanh(lo[j]); hi[j] = gelu_tanh(hi[j]); }
            *(u32x4*)(Y + (size_t)r * DM + c0) = pk8(lo, hi);
        } else *(u32x4*)(XP + (size_t)r * DM + (c0 - 1024)) = pk8(lo, hi);
        return 0.f;
    }
    __device__ __forceinline__ void row_end(int, float) const {}
    static constexpr bool HAS_ROW_END = false;
};
struct EpiGates {
    const float* ba; const float* bi; const float* sp8; const bf16_t* XC; bf16_t* LAU;
    struct Ctx { int dummy; };
    __device__ __forceinline__ Ctx row(int) const { return Ctx{0}; }
    __device__ __forceinline__ float apply(const Ctx&, int r, int c0, f32x4 lo, f32x4 hi) const {
        const int grp = c0 >> 9, q = (c0 & 511) >> 3, ch = grp * 256 + 4 * q;
        const f32x4 b_a = *(const f32x4*)(ba + ch), b_i = *(const f32x4*)(bi + ch), sp = *(const f32x4*)(sp8 + ch);
        const u32x2 xw = *(const u32x2*)(XC + (size_t)r * DM + ch);
        const float xc[4] = {bf2f(xw.x & 0xffffu), bf2f(xw.x >> 16), bf2f(xw.y & 0xffffu), bf2f(xw.y >> 16)};
        unsigned w[4];
#pragma unroll
        for (int j = 0; j < 4; ++j) {
            const float rg = sigmoidf_(lo[j] + b_a[j]), ig = sigmoidf_(hi[j] + b_i[j]);
            const float la = -rg * sp[j];
            const float t = 2.0f * la;
            const float om = (t > -0.05f) ? -t * (1.0f + t * (0.5f + t * (0.16666667f + t * 0.041666668f))) : 1.0f - __expf(t);
            const float u = sqrtf(fmaxf(om, 0.f)) * ig * xc[j];
            w[j] = pk2(la, u);
        }
        u32x4 o; o.x = w[0]; o.y = w[1]; o.z = w[2]; o.w = w[3];
        *(u32x4*)(LAU + ((size_t)r * DM + ch) * 2) = o; return 0.f;
    }
    __device__ __forceinline__ void row_end(int, float) const {}
    static constexpr bool HAS_ROW_END = false;
};

__global__ void __launch_bounds__(256) k_prologue(Params p) {
    __shared__ float scr[4][64 * 33];
    const int lane = threadIdx.x & 63, wave = threadIdx.x >> 6;
    prologue_work(p, blockIdx.x * 4 + wave, gridDim.x * 4, lane, (LAS float*)&scr[wave][0]);
}

template <class Epi>
__global__ void __launch_bounds__(256) k_gemm_naive(const bf16_t* A, int lda, const bf16_t* Bt, int ldb, int K, int agrp, Epi epi) {
    __shared__ float As[32][68]; __shared__ float Bs[32][132];
    const int tid = threadIdx.x, tx = tid & 15, ty = tid >> 4;
    const int n0 = blockIdx.x * 128, m0 = blockIdx.y * 64;
    const int acol = agrp ? (n0 >> 9) * 256 : 0;
    float acc[4][8];
#pragma unroll
    for (int i = 0; i < 4; ++i)
#pragma unroll
        for (int j = 0; j < 8; ++j) acc[i][j] = 0.f;
    for (int k0 = 0; k0 < K; k0 += 32) {
        { const int row = tid >> 2, kc = (tid & 3) * 8; float f[8]; unpk8(*(const u32x4*)(A + (size_t)(m0 + row) * lda + acol + k0 + kc), f);
#pragma unroll
          for (int e = 0; e < 8; ++e) As[kc + e][row] = f[e]; }
#pragma unroll
        for (int j = 0; j < 2; ++j) { const int idx = tid + 256 * j, row = idx >> 2, kc = (idx & 3) * 8; float f[8]; unpk8(*(const u32x4*)(Bt + (size_t)(n0 + row) * ldb + k0 + kc), f);
#pragma unroll
          for (int e = 0; e < 8; ++e) Bs[kc + e][row] = f[e]; }
        __syncthreads();
#pragma unroll 4
        for (int k = 0; k < 32; ++k) {
            const f32x4 a = *(const f32x4*)&As[k][ty * 4]; const f32x4 b0 = *(const f32x4*)&Bs[k][tx * 8], b1 = *(const f32x4*)&Bs[k][tx * 8 + 4];
#pragma unroll
            for (int i = 0; i < 4; ++i) {
#pragma unroll
                for (int j = 0; j < 4; ++j) { acc[i][j] += a[i] * b0[j]; acc[i][4 + j] += a[i] * b1[j]; } }
        }
        __syncthreads();
    }
#pragma unroll
    for (int i = 0; i < 4; ++i) { const int r = m0 + ty * 4 + i; const typename Epi::Ctx c = epi.row(r);
        const float s = epi.apply(c, r, n0 + tx * 8, (f32x4){acc[i][0], acc[i][1], acc[i][2], acc[i][3]}, (f32x4){acc[i][4], acc[i][5], acc[i][6], acc[i][7]});
        if (Epi::HAS_ROW_END) epi.row_end(r, s); }
}

constexpr int ATN_LDS = (64 * 129 * 2 + 64 * 128 + 2 * 64 * 65 + 256) * 4;
static_assert(ATN_LDS <= 135168, "simple attention scratch must stay below the LDS control words");
__global__ void __launch_bounds__(256) k_attn_naive(Params p) {
    extern __shared__ __attribute__((aligned(16))) float sm[];
    float* Qs = sm; float* Ks = Qs + 64 * 129; float* Vs = Ks + 64 * 129; float* Ss = Vs + 64 * 128; float* scl = Ss + 2 * 64 * 65; float* linv = scl + 128;
    const int tid = threadIdx.x;
    const int wg = blockIdx.x; const int qc = 63 - (wg >> 6), bh = wg & 63, b = bh >> 3, h = bh & 7;
    const bf16_t* Qg = (const bf16_t*)(p.ws + WS_Q); const bf16_t* Kg = (const bf16_t*)(p.ws + WS_K); const bf16_t* Vg = (const bf16_t*)(p.ws + WS_V);
    bf16_t* Og = (bf16_t*)(p.ws + WS_Q);
    const float lam = ((const float*)(p.ws + WS_PAR))[0];
    const size_t rowq = (size_t)b * SEQ + qc * 64;
#pragma unroll
    for (int i = 0; i < 4; ++i) { const int idx = tid + 256 * i, row = idx >> 4, pc = idx & 15; float f[8]; unpk8(*(const u32x4*)(Qg + (rowq + row) * DM + h * 128 + pc * 8), f);
#pragma unroll
        for (int e = 0; e < 8; ++e) Qs[row * 129 + pc * 8 + e] = f[e]; }
    const int r = tid >> 2, part = tid & 3;
    float o1[32], o2[32];
#pragma unroll
    for (int j = 0; j < 32; ++j) { o1[j] = 0.f; o2[j] = 0.f; }
    float mrun = -INFINITY, lrun = 0.f;
    for (int jt = 0; jt <= qc; ++jt) {
        const size_t rowk = (size_t)b * SEQ + jt * 64;
        __syncthreads();
#pragma unroll
        for (int i = 0; i < 4; ++i) { const int idx = tid + 256 * i, row = idx >> 4, pc = idx & 15; float f[8];
            unpk8(*(const u32x4*)(Kg + (rowk + row) * DM + h * 128 + pc * 8), f);
#pragma unroll
            for (int e = 0; e < 8; ++e) Ks[row * 129 + pc * 8 + e] = f[e];
            unpk8(*(const u32x4*)(Vg + (rowk + row) * DM + h * 128 + pc * 8), f);
#pragma unroll
            for (int e = 0; e < 8; ++e) Vs[row * 128 + pc * 8 + e] = f[e]; }
        __syncthreads();
#pragma unroll
        for (int c = 0; c < 2; ++c) {
            float acc[16];
#pragma unroll
            for (int kk = 0; kk < 16; ++kk) acc[kk] = 0.f;
            for (int d = 0; d < 64; ++d) { const float qv = Qs[r * 129 + c * 64 + d];
#pragma unroll
                for (int kk = 0; kk < 16; ++kk) acc[kk] += qv * Ks[(part * 16 + kk) * 129 + c * 64 + d]; }
#pragma unroll
            for (int kk = 0; kk < 16; ++kk) Ss[(c * 64 + r) * 65 + part * 16 + kk] = acc[kk];
        }
        __syncthreads();
        if (tid < 128) { float* s = Ss + tid * 65; float mx = -INFINITY;
            for (int k = 0; k < 64; ++k) mx = fmaxf(mx, s[k]);
            const float mn = fmaxf(mrun, mx), sc = exp2f(mrun - mn); float sum = 0.f;
            for (int k = 0; k < 64; ++k) { const float e = exp2f(s[k] - mn); s[k] = e; sum += e; }
            lrun = lrun * sc + sum; mrun = mn; scl[tid] = sc; }
        __syncthreads();
        { const float s1 = scl[r], s2 = scl[64 + r];
#pragma unroll
          for (int j = 0; j < 32; ++j) { o1[j] *= s1; o2[j] *= s2; }
          for (int k = 0; k < 64; ++k) { const float p1 = Ss[r * 65 + k], p2 = Ss[(64 + r) * 65 + k];
#pragma unroll
              for (int j4 = 0; j4 < 8; ++j4) { const f32x4 v = *(const f32x4*)&Vs[k * 128 + part * 32 + 4 * j4];
#pragma unroll
                  for (int e = 0; e < 4; ++e) { o1[4 * j4 + e] += p1 * v[e]; o2[4 * j4 + e] += p2 * v[e]; } } } }
    }
    __syncthreads();
    if (tid < 128) linv[tid] = 1.0f / lrun;
    __syncthreads();
    { const float i1 = linv[r], i2 = linv[64 + r] * lam; float ss = 0.f;
#pragma unroll
      for (int j = 0; j < 32; ++j) { o1[j] = o1[j] * i1 - o2[j] * i2; ss += o1[j] * o1[j]; }
      ss += __shfl_xor(ss, 1); ss += __shfl_xor(ss, 2);
      const float rn = rsqrtf(ss * (1.0f / 128.0f) + SUBLN_EPS) * (1.0f - LAMBDA_INIT);
      const float* g = p.in[I_SUBG] + part * 32;
      bf16_t* orow = Og + (rowq + r) * DM + h * 128 + part * 32;
#pragma unroll
      for (int j8 = 0; j8 < 4; ++j8) { f32x4 a, bq;
#pragma unroll
          for (int e = 0; e < 4; ++e) { a[e] = o1[8 * j8 + e] * rn * g[8 * j8 + e]; bq[e] = o1[8 * j8 + 4 + e] * rn * g[8 * j8 + 4 + e]; }
          *(u32x4*)(orow + 8 * j8) = pk8(a, bq); } }
}

__global__ void __launch_bounds__(256) k_conv(Params p) {
    const bf16_t* XP = (const bf16_t*)(p.ws + WS_XP); bf16_t* XC = (bf16_t*)(p.ws + WS_XC);
    const float* cw = p.in[I_CONVW]; const float* cb = p.in[I_CONVB];
    for (size_t i = (size_t)blockIdx.x * 256 + threadIdx.x; i < (size_t)M * 128; i += (size_t)gridDim.x * 256) {
        const int row = (int)(i >> 7), c = (int)(i & 127) * 8, t = row & (SEQ - 1);
        float acc[8];
#pragma unroll
        for (int e = 0; e < 8; ++e) acc[e] = cb[c + e];
#pragma unroll
        for (int j = 0; j < 4; ++j) { const int tt = t - 3 + j; if (tt >= 0) { float f[8]; unpk8(*(const u32x4*)(XP + (size_t)(row - 3 + j) * DM + c), f);
#pragma unroll
            for (int e = 0; e < 8; ++e) acc[e] += cw[j * DM + c + e] * f[e]; } }
        *(u32x4*)(XC + (size_t)row * DM + c) = pk8((f32x4){acc[0], acc[1], acc[2], acc[3]}, (f32x4){acc[4], acc[5], acc[6], acc[7]});
    }
}

__global__ void __launch_bounds__(256) k_scan_naive(Params p) {
    const unsigned* LAU = (const unsigned*)(p.ws + WS_LAU); bf16_t* Y = (bf16_t*)(p.ws + WS_Y);
    const int id = blockIdx.x * 256 + threadIdx.x; const int b = id >> 10, c = id & 1023;
    float h = 0.f;
    const size_t base = (size_t)b * SEQ * DM + c;
#pragma unroll 8
    for (int t = 0; t < SEQ; ++t) { const unsigned w = LAU[base + (size_t)t * DM]; const float la = bf2f(w & 0xffffu), u = bf2f(w >> 16);
        h = __expf(la) * h + u; const float y = bf2f(Y[base + (size_t)t * DM]); Y[base + (size_t)t * DM] = (bf16_t)f2bf(h * y); }
}

__global__ void __launch_bounds__(256) k_final_norm(Params p) {
    const int lane = threadIdx.x & 63; const int gw = blockIdx.x * 4 + (threadIdx.x >> 6), nw = gridDim.x * 4;
    const f32x4* g4 = (const f32x4*)p.in[I_FING] + lane;
    for (int m = gw; m < M; m += nw) { f32x4* xr = (f32x4*)(p.out + (size_t)m * DM) + lane; f32x4 v[4]; float s = 0.f;
#pragma unroll
        for (int j = 0; j < 4; ++j) { v[j] = xr[64 * j]; s += (v[j].x * v[j].x + v[j].y * v[j].y) + (v[j].z * v[j].z + v[j].w * v[j].w); }
        const float rs = rsqrtf(wave_sum(s) * (1.0f / DM) + NORM_EPS);
#pragma unroll
        for (int j = 0; j < 4; ++j) xr[64 * j] = v[j] * rs * g4[64 * j]; }
}


namespace pg8 {
#define PG8_LAS __attribute__((address_space(3)))
typedef short bf16x8 __attribute__((ext_vector_type(8)));
constexpr int BM = 256, BK = 64, HALF = 128, HTB = HALF * BK * 2  , STAGE_BYTES = 8 * HTB, NXCD = 8, WGM = 8;
__host__ __device__ __forceinline__ int lds_byte(int r, int c) { const int st = (r >> 4) * 2 + (c >> 5), rr = r & 15, cc = c & 31, ob = rr * 64 + cc * 2; return st * 1024 + (ob ^ (((ob >> 9) & 1) << 5)); }
__host__ __device__ __forceinline__ void stage_rc(int b, int& R, int& C) { const int st = b / 1024, sb = b % 1024, swz = sb ^ (((sb >> 9) & 1) << 5); R = (st >> 1) * 16 + swz / 64; C = (st & 1) * 32 + (swz % 64) / 2; }
__host__ __device__ __forceinline__ int perm32(int rho) { const int n = rho >> 4, i = rho & 15; return 8 * (i >> 2) + 4 * n + (i & 3); }
struct Unit { int pm, pn; };
struct Gemm { const bf16_t* A; const bf16_t* Bt; int M, N, K, lda, ldb, agrp; };
struct StaticOrder {
    int nM, nN, nwg, G, c;
    __host__ __device__ void init(int M, int N, int G_, int c_) { nM = M / BM; nN = N / BM; nwg = nM * nN; G = G_; c = c_; }
    __host__ __device__ bool next(int i, Unit& u) const {
        const long L = (long)i * G + c; if (L >= nwg) return false;
        int wgid = (int)L; { const int q = nwg / NXCD, r = nwg % NXCD, xcd = wgid % NXCD, off = wgid / NXCD; wgid = (xcd < r ? xcd * (q + 1) : r * (q + 1) + (xcd - r) * q) + off; }
        const int nig = WGM * nN, gid = wgid / nig, fm = gid * WGM, gsz = (nM - fm) < WGM ? (nM - fm) : WGM;
        u.pm = fm + ((wgid % nig) % gsz); u.pn = (wgid % nig) / gsz; return true;
    }
    __device__ __forceinline__ void a_ready(const Unit&) const {}
    __device__ __forceinline__ void done(const Unit&) const {}
};
template <class E8> struct EpiAdapt {
    static constexpr bool PERM = true, AFTER_DRAIN = false; E8 e;
    __device__ __forceinline__ void operator()(const f32x4 (&acc)[2][2][4][2], const Unit& u, int wr, int wc, int fr, int fq) const {
#pragma unroll
        for (int ai = 0; ai < 2; ++ai)
#pragma unroll
            for (int m = 0; m < 4; ++m) { const int row = u.pm * BM + ai * HALF + wr * 64 + m * 16 + fr; const typename E8::Ctx cx = e.row(row); float s = 0.f;
#pragma unroll
                for (int bj = 0; bj < 2; ++bj) s += e.apply(cx, row, u.pn * BM + bj * HALF + wc * 32 + 8 * fq, acc[ai][bj][m][0], acc[ai][bj][m][1]);
                if (E8::HAS_ROW_END) { s += __shfl_xor(s, 16); s += __shfl_xor(s, 32); if (fq == 0) e.row_end(row, s); } }
    }
};
template <class Epi, class Sched, bool ALIGN_EPI = false, bool SP2 = false>
__device__ __forceinline__ void gemm_phase(PG8_LAS unsigned char* lds, const Gemm g, const Sched& S, const Epi& E) {
    const int tid = threadIdx.x, wid = __builtin_amdgcn_readfirstlane(tid >> 6), lane = tid & 63, wr = wid >> 2, wc = wid & 3, fr = lane & 15, fq = lane >> 4;
    const int K = g.K, nt = K / BK;
    unsigned voffA[2], voffB[2];
#pragma unroll
    for (int i = 0; i < 2; ++i) { int R, C; stage_rc(tid * 16 + i * 8192, R, C); const int Rb = Epi::PERM ? ((R & ~31) + perm32(R & 31)) : R;
        voffA[i] = (unsigned)(R * g.lda + C) * 2u; voffB[i] = (unsigned)(Rb * g.ldb + C) * 2u; }
    const size_t kstep = (size_t)(BK * 2);
    const size_t hstepA = (size_t)HALF * g.lda * 2, hstepB = (size_t)HALF * g.ldb * 2;
    const size_t tstepA = 2 * hstepA, tstepB = 2 * hstepB;
#define PG8_ABASE(un) ((const char*)g.A + (size_t)(un).pm * tstepA + (g.agrp ? (size_t)((un).pn >> 1) * 512 : (size_t)0))
    const unsigned ldsw = (unsigned)wid * 1024u;
    const int aoff = lds_byte(wr * 64 + fr, fq * 8), boff = lds_byte(wc * 32 + fr, fq * 8);
#define PG8_SA(b, h) (((b) * 2 + (h)) * HTB)
#define PG8_SB(b, h) ((4 + (b) * 2 + (h)) * HTB)
#define PG8_STAGE(bufoff, gbase, voff) do { _Pragma("unroll") for (int _i = 0; _i < 2; ++_i) \
        __builtin_amdgcn_global_load_lds((const unsigned*)((const char*)(gbase) + (voff)[_i]), (PG8_LAS unsigned*)(lds + (bufoff) + ldsw + _i * 8192), 16, 0, 0); } while (0)
#define PG8_LDA(dst, b, h) do { _Pragma("unroll") for (int m = 0; m < 4; ++m) _Pragma("unroll") for (int k = 0; k < 2; ++k) dst[m][k] = *(const PG8_LAS bf16x8*)(lds + PG8_SA(b, h) + aoff + m * 2048 + k * 1024); } while (0)
#define PG8_LDB(dst, b, h) do { _Pragma("unroll") for (int n = 0; n < 2; ++n) _Pragma("unroll") for (int k = 0; k < 2; ++k) dst[n][k] = *(const PG8_LAS bf16x8*)(lds + PG8_SB(b, h) + boff + n * 2048 + k * 1024); } while (0)
#define PG8_MMA(ai, bj, At, Bt) do { __builtin_amdgcn_s_setprio(1); _Pragma("unroll") for (int m = 0; m < 4; ++m) _Pragma("unroll") for (int n = 0; n < 2; ++n) _Pragma("unroll") for (int k = 0; k < 2; ++k) \
        acc[ai][bj][m][n] = __builtin_amdgcn_mfma_f32_16x16x32_bf16(Bt[n][k], At[m][k], acc[ai][bj][m][n], 0, 0, 0); __builtin_amdgcn_s_setprio(0); } while (0)
#define PG8_WAIT_V(n) asm volatile("s_waitcnt vmcnt(" #n ")" ::: "memory")
#define PG8_WAIT_L(n) asm volatile("s_waitcnt lgkmcnt(" #n ")" ::: "memory")
#define PG8_BAR __builtin_amdgcn_s_barrier()
#define PG8_SCHED __builtin_amdgcn_sched_barrier(0)
    Unit cur, nxt; int ui = 0;
    if (!S.next(0, cur)) return;
    f32x4 acc[2][2][4][2];
#pragma unroll
    for (int a = 0; a < 2; ++a)
#pragma unroll
        for (int b = 0; b < 2; ++b)
#pragma unroll
            for (int m = 0; m < 4; ++m)
#pragma unroll
                for (int n = 0; n < 2; ++n) acc[a][b][m][n] = (f32x4){0.f, 0.f, 0.f, 0.f};
    bf16x8 At[4][2], B0[2][2], B1[2][2];
    const char* cA = PG8_ABASE(cur); const char* cB = (const char*)g.Bt + (size_t)cur.pn * tstepB;
    S.a_ready(cur);
    if constexpr (SP2) {
        PG8_STAGE(PG8_SB(0, 0), cB, voffB); PG8_STAGE(PG8_SB(0, 1), cB + hstepB, voffB); PG8_STAGE(PG8_SA(0, 0), cA, voffA); PG8_STAGE(PG8_SA(0, 1), cA + hstepA, voffA);
        if (wr == 1) PG8_BAR;
        PG8_WAIT_V(2); PG8_BAR;
        PG8_STAGE(PG8_SB(1, 0), cB + kstep, voffB); PG8_STAGE(PG8_SA(1, 0), cA + kstep, voffA); PG8_STAGE(PG8_SB(1, 1), cB + hstepB + kstep, voffB);
        PG8_WAIT_V(6); PG8_BAR;
    } else {
        PG8_STAGE(PG8_SB(0, 0), cB, voffB); PG8_STAGE(PG8_SA(0, 0), cA, voffA); PG8_STAGE(PG8_SB(0, 1), cB + hstepB, voffB); PG8_STAGE(PG8_SA(0, 1), cA + hstepA, voffA);
        if (wr == 1) PG8_BAR;
        PG8_WAIT_V(4); PG8_BAR;
        PG8_STAGE(PG8_SB(1, 0), cB + kstep, voffB); PG8_STAGE(PG8_SA(1, 0), cA + kstep, voffA); PG8_STAGE(PG8_SB(1, 1), cB + hstepB + kstep, voffB);
        PG8_WAIT_V(6); PG8_BAR;
    }
    for (;;) {
        const bool has_next = S.next(ui + 1, nxt);
        const char* nA = has_next ? PG8_ABASE(nxt) : cA; const char* nB = has_next ? (const char*)g.Bt + (size_t)nxt.pn * tstepB : cB;
        for (int t = 0; t < nt; t += 2) {
            const bool last = (t == nt - 2);
            const char* a1 = cA + (size_t)(t + 1) * kstep;
            const char* a2 = last ? nA : cA + (size_t)(t + 2) * kstep; const char* b2 = last ? nB : cB + (size_t)(t + 2) * kstep;
            const char* a3 = a2 + kstep; const char* b3 = b2 + kstep;
            if (last && has_next) S.a_ready(nxt);
            if constexpr (SP2) {
            PG8_LDB(B0, 0, 0); PG8_LDB(B1, 0, 1); PG8_SCHED; PG8_LDA(At, 0, 0); PG8_STAGE(PG8_SA(1, 1), a1 + hstepA, voffA);
            PG8_WAIT_V(8); PG8_WAIT_L(0); PG8_BAR; PG8_MMA(0, 0, At, B0); PG8_MMA(0, 1, At, B1); PG8_BAR; PG8_SCHED;
            PG8_LDA(At, 0, 1); PG8_STAGE(PG8_SB(0, 0), b2, voffB); PG8_STAGE(PG8_SB(0, 1), b2 + hstepB, voffB); PG8_STAGE(PG8_SA(0, 0), a2, voffA);
            PG8_WAIT_V(8); PG8_WAIT_L(0); PG8_BAR; PG8_MMA(1, 0, At, B0); PG8_MMA(1, 1, At, B1); PG8_BAR; PG8_SCHED;
            PG8_LDB(B0, 1, 0); PG8_LDB(B1, 1, 1); PG8_SCHED; PG8_LDA(At, 1, 0); PG8_STAGE(PG8_SA(0, 1), a2 + hstepA, voffA);
            PG8_WAIT_V(8); PG8_WAIT_L(0); PG8_BAR; PG8_MMA(0, 0, At, B0); PG8_MMA(0, 1, At, B1); PG8_BAR; PG8_SCHED;
            PG8_LDA(At, 1, 1); PG8_STAGE(PG8_SB(1, 0), b3, voffB); PG8_STAGE(PG8_SB(1, 1), b3 + hstepB, voffB); PG8_STAGE(PG8_SA(1, 0), a3, voffA);
            PG8_WAIT_V(8); PG8_WAIT_L(0); PG8_BAR; PG8_MMA(1, 0, At, B0); PG8_MMA(1, 1, At, B1); PG8_BAR; PG8_SCHED;
            } else {
            PG8_LDB(B0, 0, 0); PG8_SCHED; PG8_LDA(At, 0, 0); PG8_STAGE(PG8_SA(1, 1), a1 + hstepA, voffA);
            PG8_WAIT_L(8); PG8_BAR; PG8_WAIT_L(0); PG8_MMA(0, 0, At, B0); PG8_BAR; PG8_SCHED;
            PG8_LDB(B1, 0, 1); PG8_STAGE(PG8_SB(0, 0), b2, voffB);
            PG8_BAR; PG8_WAIT_L(0); PG8_MMA(0, 1, At, B1); PG8_BAR;
            PG8_LDA(At, 0, 1); PG8_STAGE(PG8_SA(0, 0), a2, voffA);
            PG8_BAR; PG8_WAIT_L(0); PG8_MMA(1, 0, At, B0); PG8_BAR; PG8_SCHED;
            PG8_STAGE(PG8_SB(0, 1), b2 + hstepB, voffB);
            PG8_WAIT_V(6); PG8_BAR; PG8_MMA(1, 1, At, B1); PG8_BAR;
            PG8_LDB(B0, 1, 0); PG8_SCHED; PG8_LDA(At, 1, 0); PG8_STAGE(PG8_SA(0, 1), a2 + hstepA, voffA);
            PG8_WAIT_L(8); PG8_BAR; PG8_WAIT_L(0); PG8_MMA(0, 0, At, B0); PG8_BAR; PG8_SCHED;
            PG8_LDB(B1, 1, 1); PG8_STAGE(PG8_SB(1, 0), b3, voffB);
            PG8_BAR; PG8_WAIT_L(0); PG8_MMA(0, 1, At, B1); PG8_BAR;
            PG8_LDA(At, 1, 1); PG8_STAGE(PG8_SA(1, 0), a3, voffA);
            PG8_BAR; PG8_WAIT_L(0); PG8_MMA(1, 0, At, B0); PG8_BAR; PG8_SCHED;
            PG8_STAGE(PG8_SB(1, 1), b3 + hstepB, voffB);
            PG8_WAIT_V(6); PG8_BAR; PG8_MMA(1, 1, At, B1); PG8_BAR;
            }
        }
        if constexpr (ALIGN_EPI) { if (wr == 0) PG8_BAR; }
        if constexpr (!Epi::AFTER_DRAIN) { E(acc, cur, wr, wc, fr, fq); S.done(cur); }
        if (!has_next) break;
#pragma unroll
        for (int a = 0; a < 2; ++a)
#pragma unroll
            for (int b = 0; b < 2; ++b)
#pragma unroll
                for (int m = 0; m < 4; ++m)
#pragma unroll
                    for (int n = 0; n < 2; ++n) acc[a][b][m][n] = (f32x4){0.f, 0.f, 0.f, 0.f};
        cur = nxt; cA = nA; cB = nB; ++ui;
        if constexpr (ALIGN_EPI) { if (wr == 1) PG8_BAR; }
    }
    PG8_WAIT_V(0);
    if constexpr (!ALIGN_EPI) { if (wr == 0) PG8_BAR; }
    PG8_BAR;
    if constexpr (Epi::AFTER_DRAIN) { E.fused(acc, cur, wr, wc, fr, fq, lds, wid, lane); S.done(cur); }
#undef PG8_SA
#undef PG8_SB
#undef PG8_STAGE
#undef PG8_LDA
#undef PG8_LDB
#undef PG8_MMA
#undef PG8_WAIT_V
#undef PG8_WAIT_L
#undef PG8_BAR
#undef PG8_SCHED
#undef PG8_ABASE
}
}

constexpr int NWAVES = 8;
constexpr int RING_BYTES = 131072, LDSCTL_OFF = 135168, MISC_OFF = LDSCTL_OFF + 320, LDS_BYTES = 147456;
constexpr int CW_BAR = 4096;
constexpr int NPH = 14;
#define GAS __attribute__((address_space(1)))
typedef GAS unsigned gu32;
#define RLX_AGENT __ATOMIC_RELAXED, __HIP_MEMORY_SCOPE_AGENT
#define XB_TMO      128
#define XB_XCNT(j)  (256  + 64 * (j))
#define XB_XSUB(j)  (1280 + 64 * (j))
#define XB_XGEN(j)  (2304 + 64 * (j))
#define XB_TOP      3328
#define XB_TOPGEN   3392
#define XCD_BAR_WORDS 3456
#define XB_SPIN_CAP (1u << 18)

__device__ __forceinline__ unsigned xb_ld(unsigned* p)              { return __hip_atomic_load(p, __ATOMIC_RELAXED, __HIP_MEMORY_SCOPE_AGENT); }
__device__ __forceinline__ unsigned xb_add(unsigned* p, unsigned v) { return __hip_atomic_fetch_add(p, v, __ATOMIC_RELAXED, __HIP_MEMORY_SCOPE_AGENT); }
__device__ __forceinline__ unsigned xb_xcc_id() { return (unsigned)__builtin_amdgcn_s_getreg((3 << 11) | 20) & 0xFu; }
#define XB_SPIN(cond, bar) do { unsigned _sp = 0; while (cond) { __builtin_amdgcn_s_sleep(1); \
    if ((++_sp & 255u) == 0u) { if (xb_ld(&(bar)[XB_TMO])) break; if (_sp > XB_SPIN_CAP) { atomicAdd(&(bar)[XB_TMO], 1u); break; } } } } while (0)

struct XcdBarrier {
    unsigned* bar; unsigned x;
    volatile LAS unsigned* st;
};

__device__ __forceinline__ XcdBarrier xcd_barrier_post(unsigned* bar, volatile LAS unsigned* st) {
    XcdBarrier b; b.bar = bar; b.x = xb_xcc_id(); b.st = st;
    if (threadIdx.x == 0) (void)xb_add(&bar[XB_XCNT(b.x)], 1u);
    return b;
}
__device__ __forceinline__ void xcd_barrier_complete(unsigned* bar, unsigned x, unsigned& nloc, unsigned& nx) {
    const unsigned G = gridDim.x * gridDim.y * gridDim.z;
    unsigned sum, cnt, mine, sp = 0u;
    for (;;) {
        sum = 0u; cnt = 0u; mine = 0u;
#pragma unroll
        for (unsigned j = 0; j < 16; ++j) { const unsigned c = xb_ld(&bar[XB_XCNT(j)]); sum += c; cnt += (c > 0u) ? 1u : 0u; mine = (j == x) ? c : mine; }
        if (sum == G) break;
        __builtin_amdgcn_s_sleep(1);
        if ((++sp & 255u) == 0u) { if (xb_ld(&bar[XB_TMO])) break; if (sp > XB_SPIN_CAP) { atomicAdd(&bar[XB_TMO], 1u); break; } }
    }
    nloc = mine > 0u ? mine : 1u; nx = cnt > 0u ? cnt : 1u;
}

__device__ __forceinline__ void xcd_barrier(const XcdBarrier& b) {
    asm volatile("s_waitcnt vmcnt(0)" ::: "memory");
    __syncthreads();
    if (threadIdx.x == 0) {
        unsigned* bar = b.bar;
        __builtin_amdgcn_s_waitcnt(0);
        unsigned nloc = b.st[0], nx = b.st[1];
        if (nloc == 0u) { xcd_barrier_complete(bar, b.x, nloc, nx); b.st[0] = nloc; b.st[1] = nx; }
        const unsigned old = xb_add(&bar[XB_XSUB(b.x)], 1u);
        const unsigned gen = old / nloc;
        if (old + 1u == (gen + 1u) * nloc) {
            __builtin_amdgcn_fence(__ATOMIC_RELEASE, "agent");
            asm volatile("s_waitcnt vmcnt(0)" ::: "memory");
            const unsigned og = xb_add(&bar[XB_TOP], 1u);
            const unsigned tg = og / nx;
            if (og + 1u == (tg + 1u) * nx) xb_add(&bar[XB_TOPGEN], 1u);
            else XB_SPIN(xb_ld(&bar[XB_TOPGEN]) == tg, bar);
            __builtin_amdgcn_fence(__ATOMIC_ACQUIRE, "agent");
            xb_add(&bar[XB_XGEN(b.x)], 1u);
            asm volatile("s_waitcnt vmcnt(0)" ::: "memory");
        } else {
            XB_SPIN(xb_ld(&bar[XB_XGEN(b.x)]) == gen, bar);
            __builtin_amdgcn_fence(__ATOMIC_ACQUIRE, "agent");
            asm volatile("s_waitcnt vmcnt(0)" ::: "memory");
        }
    }
    __syncthreads();
}


__device__ __forceinline__ void attn_simple_unit(const Params& p, LAS float* sm, int wg) {
    LAS float* Qs = sm; LAS float* Ks = Qs + 64 * 129; LAS float* Vs = Ks + 64 * 129; LAS float* Ss = Vs + 64 * 128; LAS float* scl = Ss + 2 * 64 * 65; LAS float* linv = scl + 128;
    const int tid = threadIdx.x;
    const int qc = 63 - (wg >> 6), bh = wg & 63, b = bh >> 3, h = bh & 7;
    const bf16_t* Qg = (const bf16_t*)(p.ws + WS_Q); const bf16_t* Kg = (const bf16_t*)(p.ws + WS_K); const bf16_t* Vg = (const bf16_t*)(p.ws + WS_V);
    bf16_t* Og = (bf16_t*)(p.ws + WS_Q);
    const float lam = ((const float*)(p.ws + WS_PAR))[0];
    const size_t rowq = (size_t)b * SEQ + qc * 64;
    __syncthreads();
#pragma unroll
    for (int i = 0; i < 2; ++i) { const int idx = tid + 512 * i, row = idx >> 4, pc = idx & 15; float f[8]; unpk8(*(const u32x4*)(Qg + (rowq + row) * DM + h * 128 + pc * 8), f);
#pragma unroll
        for (int e = 0; e < 8; ++e) Qs[row * 129 + pc * 8 + e] = f[e]; }
    const int r = tid >> 3, part = tid & 7;
    float o1[16], o2[16];
#pragma unroll
    for (int j = 0; j < 16; ++j) { o1[j] = 0.f; o2[j] = 0.f; }
    float mrun = -INFINITY, lrun = 0.f;
    for (int jt = 0; jt <= qc; ++jt) {
        const size_t rowk = (size_t)b * SEQ + jt * 64;
        __syncthreads();
#pragma unroll
        for (int i = 0; i < 2; ++i) { const int idx = tid + 512 * i, row = idx >> 4, pc = idx & 15; float f[8];
            unpk8(*(const u32x4*)(Kg + (rowk + row) * DM + h * 128 + pc * 8), f);
#pragma unroll
            for (int e = 0; e < 8; ++e) Ks[row * 129 + pc * 8 + e] = f[e];
            unpk8(*(const u32x4*)(Vg + (rowk + row) * DM + h * 128 + pc * 8), f);
#pragma unroll
            for (int e = 0; e < 8; ++e) Vs[row * 128 + pc * 8 + e] = f[e]; }
        __syncthreads();
#pragma unroll
        for (int c = 0; c < 2; ++c) {
            float acc[8];
#pragma unroll
            for (int kk = 0; kk < 8; ++kk) acc[kk] = 0.f;
            for (int d = 0; d < 64; ++d) { const float qv = Qs[r * 129 + c * 64 + d];
#pragma unroll
                for (int kk = 0; kk < 8; ++kk) acc[kk] += qv * Ks[(part * 8 + kk) * 129 + c * 64 + d]; }
#pragma unroll
            for (int kk = 0; kk < 8; ++kk) Ss[(c * 64 + r) * 65 + part * 8 + kk] = acc[kk];
        }
        __syncthreads();
        if (tid < 128) { LAS float* s = Ss + tid * 65; float mx = -INFINITY;
            for (int k = 0; k < 64; ++k) mx = fmaxf(mx, s[k]);
            const float mn = fmaxf(mrun, mx), sc = exp2f(mrun - mn); float sum = 0.f;
            for (int k = 0; k < 64; ++k) { const float e = exp2f(s[k] - mn); s[k] = e; sum += e; }
            lrun = lrun * sc + sum; mrun = mn; scl[tid] = sc; }
        __syncthreads();
        { const float s1 = scl[r], s2 = scl[64 + r];
#pragma unroll
          for (int j = 0; j < 16; ++j) { o1[j] *= s1; o2[j] *= s2; }
          for (int k = 0; k < 64; ++k) { const float p1 = Ss[r * 65 + k], p2 = Ss[(64 + r) * 65 + k];
#pragma unroll
              for (int j4 = 0; j4 < 4; ++j4) { const f32x4 v = *(const LAS f32x4*)&Vs[k * 128 + part * 16 + 4 * j4];
#pragma unroll
                  for (int e = 0; e < 4; ++e) { o1[4 * j4 + e] += p1 * v[e]; o2[4 * j4 + e] += p2 * v[e]; } } } }
    }
    __syncthreads();
    if (tid < 128) linv[tid] = 1.0f / lrun;
    __syncthreads();
    { const float i1 = linv[r], i2 = linv[64 + r] * lam; float ss = 0.f;
#pragma unroll
      for (int j = 0; j < 16; ++j) { o1[j] = o1[j] * i1 - o2[j] * i2; ss += o1[j] * o1[j]; }
      ss += __shfl_xor(ss, 1); ss += __shfl_xor(ss, 2); ss += __shfl_xor(ss, 4);
      const float rn = rsqrtf(ss * (1.0f / 128.0f) + SUBLN_EPS) * (1.0f - LAMBDA_INIT);
      const float* g = p.in[I_SUBG] + part * 16;
      bf16_t* orow = Og + (rowq + r) * DM + h * 128 + part * 16;
#pragma unroll
      for (int j8 = 0; j8 < 2; ++j8) { f32x4 a, bq;
#pragma unroll
          for (int e = 0; e < 4; ++e) { a[e] = o1[8 * j8 + e] * rn * g[8 * j8 + e]; bq[e] = o1[8 * j8 + 4 + e] * rn * g[8 * j8 + 4 + e]; }
          *(u32x4*)(orow + 8 * j8) = pk8(a, bq); } }
}
__device__ __forceinline__ void conv_phase(const Params& p, size_t gtid, size_t nthreads) {
    const bf16_t* XP = (const bf16_t*)(p.ws + WS_XP); bf16_t* XC = (bf16_t*)(p.ws + WS_XC);
    const float* cw = p.in[I_CONVW]; const float* cb = p.in[I_CONVB];
    for (size_t i = gtid; i < (size_t)M * 128; i += nthreads) {
        const int row = (int)(i >> 7), c = (int)(i & 127) * 8, t = row & (SEQ - 1);
        float acc[8];
#pragma unroll
        for (int e = 0; e < 8; ++e) acc[e] = cb[c + e];
#pragma unroll
        for (int j = 0; j < 4; ++j) { const int tt = t - 3 + j; if (tt >= 0) { float f[8]; unpk8(*(const u32x4*)(XP + (size_t)(row - 3 + j) * DM + c), f);
#pragma unroll
            for (int e = 0; e < 8; ++e) acc[e] += cw[j * DM + c + e] * f[e]; } }
        *(u32x4*)(XC + (size_t)row * DM + c) = pk8((f32x4){acc[0], acc[1], acc[2], acc[3]}, (f32x4){acc[4], acc[5], acc[6], acc[7]});
    }
}
__device__ __forceinline__ void scan_item(const Params& p, LAS float* sm, int item) {
    const unsigned* LAU = (const unsigned*)(p.ws + WS_LAU); bf16_t* Y = (bf16_t*)(p.ws + WS_Y);
    const int tid = threadIdx.x, seg = tid >> 5, ch = tid & 31; const int b = item >> 5, cb = item & 31;
    const size_t base = ((size_t)b * SEQ + (size_t)seg * 256) * DM + cb * 32 + ch;
    float h = 0.f, A = 0.f;
#pragma unroll 8
    for (int t = 0; t < 256; ++t) { const unsigned w = LAU[base + (size_t)t * DM]; const float la = bf2f(w & 0xffffu), u = bf2f(w >> 16); h = __expf(la) * h + u; A += la; }
    __syncthreads();
    sm[tid] = A; sm[512 + tid] = h;
    __syncthreads();
    float carry = 0.f;
    for (int s2 = 0; s2 < seg; ++s2) carry = __expf(sm[s2 * 32 + ch]) * carry + sm[512 + s2 * 32 + ch];
    h = carry;
#pragma unroll 8
    for (int t = 0; t < 256; ++t) { const unsigned w = LAU[base + (size_t)t * DM]; const float la = bf2f(w & 0xffffu), u = bf2f(w >> 16); h = __expf(la) * h + u;
        const float y = bf2f(Y[base + (size_t)t * DM]); Y[base + (size_t)t * DM] = (bf16_t)f2bf(h * y); }
}
__device__ __forceinline__ void final_norm_phase(const Params& p, int gw, int nw, int lane) {
    const f32x4* g4 = (const f32x4*)p.in[I_FING] + lane;
    for (int m = gw; m < M; m += nw) { f32x4* xr = (f32x4*)(p.out + (size_t)m * DM) + lane; f32x4 v[4]; float s = 0.f;
#pragma unroll
        for (int j = 0; j < 4; ++j) { v[j] = xr[64 * j]; s += (v[j].x * v[j].x + v[j].y * v[j].y) + (v[j].z * v[j].z + v[j].w * v[j].w); }
        const float rs = rsqrtf(wave_sum(s) * (1.0f / DM) + NORM_EPS);
#pragma unroll
        for (int j = 0; j < 4; ++j) xr[64 * j] = v[j] * rs * g4[64 * j]; }
}

struct Args { Params p; int ph_lo, ph_hi, li, pad; };
__global__ void __launch_bounds__(NWAVES * 64, 2) mega(Args a) {
    extern __shared__ __attribute__((aligned(16))) unsigned char lds_raw[];
    LAS unsigned char* lds = (LAS unsigned char*)lds_raw;
    volatile LAS unsigned* MISC = (volatile LAS unsigned*)(lds + MISC_OFF);
    const int tid = threadIdx.x, lane = tid & 63, wave = __builtin_amdgcn_readfirstlane(tid >> 6);
    const int G = gridDim.x; const int bx = blockIdx.x; const int vcu = (G % 8 == 0) ? (bx % 8) * (G / 8) + bx / 8 : bx;
    unsigned char* ws = a.p.ws;
    for (int u = tid; u < (LDS_BYTES - LDSCTL_OFF) / 4; u += NWAVES * 64) ((LAS unsigned*)(lds + LDSCTL_OFF))[u] = 0u;
    __syncthreads();
    XcdBarrier bar = xcd_barrier_post((unsigned*)(ws + WS_CTL) + CW_BAR + a.li * XCD_BAR_WORDS, MISC + 8);
    const int lo = a.ph_lo, hi = a.ph_hi;
#define IN(k) (lo <= (k) && (k) < hi)
#define SEAM(k) do { if (IN(k) && IN((k) + 1)) xcd_barrier(bar); } while (0)
    float* ssq = (float*)(ws + WS_SSQ); float* par = (float*)(ws + WS_PAR);
    const float* cosT = (const float*)(ws + WS_ROPE); const float* sinT = cosT + 4096 * 32;
    bf16_t* XB = (bf16_t*)(ws + WS_XB);
#define GEMM_PHASE(ET, EOBJ, AP, LDA, BP, LDB, NN, KK, AGRP) do { pg8::Gemm g{(const bf16_t*)(AP), (const bf16_t*)(BP), M, NN, KK, LDA, LDB, AGRP}; pg8::StaticOrder S; S.init(M, NN, G, bx); \
        pg8::EpiAdapt<ET> E{EOBJ}; pg8::gemm_phase<pg8::EpiAdapt<ET>, pg8::StaticOrder, true, true>(lds, g, S, E); } while (0)
    if (IN(0)) { prologue_work(a.p, vcu * NWAVES + wave, G * NWAVES, lane, (LAS float*)(lds + wave * 16384)); SEAM(0); }
    if (IN(1)) { GEMM_PHASE(EpiQKV, (EpiQKV{ssq, cosT, sinT, (bf16_t*)(ws + WS_Q)}), XB, DM, ws + WS_WQKV, DM, 3072, DM, 0); SEAM(1); }
    if (IN(2)) { for (int wg = bx; wg < 4096; wg += G) attn_simple_unit(a.p, (LAS float*)lds, wg); __syncthreads(); SEAM(2); }
    if (IN(3)) { GEMM_PHASE(EpiRes, (EpiRes{a.p.in[I_X], a.p.out, XB, ssq + M}), ws + WS_Q, DM, ws + WS_WO, DM, DM, DM, 0); SEAM(3); }
    if (IN(4)) { GEMM_PHASE(EpiUp, (EpiUp{ssq + M, (bf16_t*)(ws + WS_H)}), XB, DM, ws + WS_W1, DM, FF, DM, 0); SEAM(4); }
    if (IN(5)) { GEMM_PHASE(EpiRes, (EpiRes{a.p.out, a.p.out, XB, ssq + 2 * M}), ws + WS_H, FF, ws + WS_W2, FF, DM, FF, 0); SEAM(5); }
    if (IN(6)) { GEMM_PHASE(EpiRecIn, (EpiRecIn{ssq + 2 * M, (bf16_t*)(ws + WS_Y), (bf16_t*)(ws + WS_XP)}), XB, DM, ws + WS_WYX, DM, 2048, DM, 0); SEAM(6); }
    if (IN(7)) { conv_phase(a.p, (size_t)vcu * (NWAVES * 64) + tid, (size_t)G * (NWAVES * 64)); SEAM(7); }
    if (IN(8)) { GEMM_PHASE(EpiGates, (EpiGates{a.p.in[I_RBA], a.p.in[I_RBI], par + 256, (const bf16_t*)(ws + WS_XC), (bf16_t*)(ws + WS_LAU)}), ws + WS_XC, DM, ws + WS_WG, 256, 2048, 256, 1); SEAM(8); }
    if (IN(9)) { for (int it = bx; it < BATCH * 32; it += G) scan_item(a.p, (LAS float*)lds, it); __syncthreads(); SEAM(9); }
    if (IN(10)) { GEMM_PHASE(EpiRes, (EpiRes{a.p.out, a.p.out, XB, ssq + 3 * M}), ws + WS_Y, DM, ws + WS_WRO, DM, DM, DM, 0); SEAM(10); }
    if (IN(11)) { GEMM_PHASE(EpiUp, (EpiUp{ssq + 3 * M, (bf16_t*)(ws + WS_H)}), XB, DM, ws + WS_W1 + 8 * MiB, DM, FF, DM, 0); SEAM(11); }
    if (IN(12)) { GEMM_PHASE(EpiRes, (EpiRes{a.p.out, a.p.out, nullptr, nullptr}), ws + WS_H, FF, ws + WS_W2 + 8 * MiB, FF, DM, FF, 0); SEAM(12); }
    if (IN(13)) { final_norm_phase(a.p, vcu * NWAVES + wave, G * NWAVES, lane); }
#undef IN
#undef SEAM
#undef GEMM_PHASE
}

constexpr unsigned NAIVE_MASK = 0u;
extern "C" void kernel_launch(void* const* d_in, const int* in_sizes, int n_in, void* d_out, int out_size, void* d_ws, size_t ws_size, hipStream_t stream) {
    static int grid = 0;
    if (grid == 0) {
        if (n_in != 23 || in_sizes[0] != M * DM || out_size != M * DM || ws_size < WS_END) { fprintf(stderr, "kernel_launch: unexpected shapes (n_in %d, in0 %d, out %d, ws %zu)\n", n_in, n_in > 0 ? in_sizes[0] : -1, out_size, ws_size); grid = -1; return; }
        if (hipFuncSetAttribute((const void*)k_attn_naive, hipFuncAttributeMaxDynamicSharedMemorySize, ATN_LDS) != hipSuccess) { fprintf(stderr, "kernel_launch: hipFuncSetAttribute failed\n"); grid = -1; return; }
        if (hipFuncSetAttribute((const void*)mega, hipFuncAttributeMaxDynamicSharedMemorySize, LDS_BYTES) != hipSuccess) { fprintf(stderr, "kernel_launch: hipFuncSetAttribute(mega) failed\n"); grid = -1; return; }
        int dev = 0, cus = 0, per_cu = 0;
        if (hipGetDevice(&dev) != hipSuccess || hipDeviceGetAttribute(&cus, hipDeviceAttributeMultiprocessorCount, dev) != hipSuccess) { grid = -1; return; }
        if (hipOccupancyMaxActiveBlocksPerMultiprocessor(&per_cu, (const void*)mega, NWAVES * 64, LDS_BYTES) != hipSuccess || per_cu < 1) { fprintf(stderr, "kernel_launch: occupancy query says %d blocks per CU\n", per_cu); grid = -1; (void)hipGetLastError(); return; }
        grid = cus;
        if (grid != 256) fprintf(stderr, "kernel_launch: note: %d CUs\n", grid);
    }
    if (grid < 0) return;
    Args a{};
    for (int i = 0; i < 23; ++i) a.p.in[i] = (const float*)d_in[i];
    a.p.out = (float*)d_out; a.p.ws = (unsigned char*)d_ws;
    (void)hipMemsetAsync((unsigned char*)d_ws + WS_CTL, 0, CTL_ZERO_BYTES, stream);
    int li = 0;
    for (int ph = 0; ph < NPH;) {
        if (NAIVE_MASK & (1u << ph)) {
            if (ph == 2) k_attn_naive<<<4096, 256, ATN_LDS, stream>>>(a.p);
            else if (ph == 7) k_conv<<<2048, 256, 0, stream>>>(a.p);
            else if (ph == 9) k_scan_naive<<<BATCH * DM / 256, 256, 0, stream>>>(a.p);
            else if (ph == 13) k_final_norm<<<2048, 256, 0, stream>>>(a.p);
            ++ph; continue;
        }
        int e = ph; while (e < NPH && !(NAIVE_MASK & (1u << e))) ++e;
        a.ph_lo = ph; a.ph_hi = e; a.li = li++;
        hipLaunchKernelGGL(mega, dim3(grid), dim3(NWAVES * 64), LDS_BYTES, stream, a);
        ph = e;
    }
}
```

```cpp
#include <hip/hip_runtime.h>
#include <stdint.h>
#include <cstdio>

#define LAS __attribute__((address_space(3)))
typedef unsigned short bf16_t;
typedef float f32x4 __attribute__((ext_vector_type(4)));
typedef unsigned u32x4 __attribute__((ext_vector_type(4)));
typedef unsigned u32x2 __attribute__((ext_vector_type(2)));

constexpr int BATCH = 8, SEQ = 4096, DM = 1024, FF = 4096, M = BATCH * SEQ;
constexpr int NH = 8;
constexpr float NORM_EPS = 1e-6f, SUBLN_EPS = 1e-5f;
constexpr float LAMBDA_INIT = 0.2f;
constexpr float C2 = 0.18033688011112042f;

constexpr size_t MiB = 1u << 20;
constexpr size_t WS_CTL = 0, CTL_ZERO_BYTES = 2 * MiB;
constexpr size_t WS_SSQ = 1 * MiB;
constexpr size_t WS_PAR = 2 * MiB;
constexpr size_t WS_ROPE = 3 * MiB;
constexpr size_t WS_WQKV = 4 * MiB, WS_WO = 10 * MiB, WS_W1 = 12 * MiB  , WS_W2 = 28 * MiB  , WS_WYX = 44 * MiB, WS_WG = 48 * MiB, WS_WRO = 49 * MiB;
constexpr size_t WS_XB = 52 * MiB;
constexpr size_t WS_R = 116 * MiB;
constexpr size_t WS_Q = WS_R, WS_K = WS_R + 64 * MiB, WS_V = WS_R + 128 * MiB, WS_H = WS_R;
constexpr size_t WS_Y = WS_R, WS_XC = WS_R + 64 * MiB, WS_XP = WS_R + 128 * MiB, WS_LAU = WS_R + 128 * MiB;
constexpr size_t WS_END = WS_R + 256 * MiB;

struct Params { const float* in[23]; float* out; unsigned char* ws; };

enum { I_X = 0, I_MIXG, I_MLPG, I_WQKV, I_WO, I_LQ1, I_LK1, I_LQ2, I_LK2, I_SUBG, I_RWX, I_RWY, I_CONVW, I_CONVB, I_RWA, I_RBA, I_RWI, I_RBI, I_RLAM, I_RWO, I_W1, I_W2, I_FING };

__device__ __forceinline__ float bf2f(unsigned b) { return __uint_as_float(b << 16); }
__device__ __forceinline__ unsigned f2bf(float f) { unsigned u = __float_as_uint(f); return (u + 0x7fffu + ((u >> 16) & 1u)) >> 16; }
__device__ __forceinline__ unsigned pk2(float lo, float hi) { return f2bf(lo) | (f2bf(hi) << 16); }
__device__ __forceinline__ u32x4 pk8(f32x4 a, f32x4 b) { u32x4 w; w.x = pk2(a[0], a[1]); w.y = pk2(a[2], a[3]); w.z = pk2(b[0], b[1]); w.w = pk2(b[2], b[3]); return w; }
__device__ __forceinline__ void unpk8(u32x4 w, float* f) { f[0] = bf2f(w.x & 0xffffu); f[1] = bf2f(w.x >> 16); f[2] = bf2f(w.y & 0xffffu); f[3] = bf2f(w.y >> 16);
    f[4] = bf2f(w.z & 0xffffu); f[5] = bf2f(w.z >> 16); f[6] = bf2f(w.w & 0xffffu); f[7] = bf2f(w.w >> 16); }
__device__ __forceinline__ float wave_sum(float v) {
#pragma unroll
    for (int o = 1; o < 64; o <<= 1) v += __shfl_xor(v, o);
    return v;
}
__device__ __forceinline__ float sigmoidf_(float x) { return 1.0f / (1.0f + __expf(-x)); }
__device__ __forceinline__ float gelu_tanh(float x) { const float z = 0.7978845608028654f * (x + 0.044715f * x * x * x); return x / (1.0f + __expf(-2.0f * z)); }

__device__ __forceinline__ int rope_phys(int d) { return d < 32 ? 8 * (d >> 2) + (d & 3) : 8 * ((d - 32) >> 2) + 4 + (d & 3); }

__device__ const double INV_FREQ[32] = {1.0, 0.7498942093324559, 0.5623413251903491, 0.4216965034285822, 0.31622776601683794, 0.23713737056616552, 0.1778279410038923, 0.1333521432163324, 0.1,
    0.07498942093324558, 0.05623413251903491, 0.042169650342858224, 0.03162277660168379, 0.023713737056616554, 0.01778279410038923, 0.01333521432163324, 0.01, 0.007498942093324558,
    0.005623413251903491, 0.004216965034285823, 0.0031622776601683794, 0.0023713737056616554, 0.0017782794100389228, 0.001333521432163324, 0.001, 0.0007498942093324559,
    0.0005623413251903491, 0.00042169650342858224, 0.00031622776601683794, 0.00023713737056616554, 0.00017782794100389227, 0.0001333521432163324};

__device__ __forceinline__ void sincos_d(double ang, float& s, float& c) {
    const double k = __builtin_rint(ang * 0.6366197723675814);
    const double r = ang - k * 1.5707963267948966;
    const double r2 = r * r;
    double sp = -1.0 / 1307674368000.0; sp = sp * r2 + 1.0 / 6227020800.0; sp = sp * r2 - 1.0 / 39916800.0; sp = sp * r2 + 1.0 / 362880.0; sp = sp * r2 - 1.0 / 5040.0; sp = sp * r2 + 1.0 / 120.0; sp = sp * r2 - 1.0 / 6.0; sp = sp * r2 + 1.0;
    const double sn = sp * r;
    double cp = 1.0 / 87178291200.0; cp = cp * r2 - 1.0 / 479001600.0; cp = cp * r2 + 1.0 / 3628800.0; cp = cp * r2 - 1.0 / 40320.0; cp = cp * r2 + 1.0 / 720.0; cp = cp * r2 - 1.0 / 24.0; cp = cp * r2 + 0.5; const double cs = 1.0 - cp * r2;
    const int q = ((int)k) & 3;
    const double ss = (q == 0) ? sn : (q == 1) ? cs : (q == 2) ? -sn : -cs;
    const double cc = (q == 0) ? cs : (q == 1) ? -sn : (q == 2) ? -cs : sn;
    s = (float)ss; c = (float)cc;
}

template <class RowMap>
__device__ __forceinline__ void tr_item(const float* W, int N, int K, bf16_t* WT, const float* g, LAS float* scr, int item, int lane, RowMap rm) {
    const int nblk = N / 32, kb = item / nblk, nb = item % nblk, k0 = 64 * kb, n0 = 32 * nb;
#pragma unroll 8
    for (int i = 0; i < 32; ++i) { const int kk = 2 * i + (lane >> 5); float v = W[(size_t)(k0 + kk) * N + n0 + (lane & 31)]; if (g) v *= g[k0 + kk]; scr[kk * 33 + (lane & 31)] = v; }
    asm volatile("s_waitcnt lgkmcnt(0)" ::: "memory");
    const int c = lane & 7;
#pragma unroll
    for (int j = 0; j < 4; ++j) { const int n = (lane >> 3) + 8 * j; const LAS float* s = scr + (8 * c) * 33 + n;
        u32x4 o; o.x = pk2(s[0 * 33], s[1 * 33]); o.y = pk2(s[2 * 33], s[3 * 33]); o.z = pk2(s[4 * 33], s[5 * 33]); o.w = pk2(s[6 * 33], s[7 * 33]);
        *(u32x4*)(WT + (size_t)rm(n0 + n) * K + k0 + 8 * c) = o; }
    asm volatile("s_waitcnt lgkmcnt(0)" ::: "memory");
}
struct MapId { int base; __device__ __forceinline__ int operator()(int n) const { return base + n; } };
struct MapQKV { __device__ __forceinline__ int operator()(int n) const { return n < 2048 ? (n & ~63) + rope_phys(n & 63) : n; } };
struct MapGate { int base; __device__ __forceinline__ int operator()(int d) const { return base + 8 * (d >> 2) + (d & 3); } };

__device__ __forceinline__ void prologue_work(const Params& p, int gw, int nw, int lane, LAS float* scr) {
    unsigned char* ws = p.ws;
    constexpr int IT_QKV = 16 * 96, IT_SQ = 16 * 32, IT_W1 = 16 * 128, IT_W2 = 64 * 32, IT_G = 4 * 8;
    constexpr int NIT = IT_QKV + IT_SQ + 2 * IT_W1 + 2 * IT_W2 + 2 * IT_SQ + 8 * IT_G + IT_SQ;
    for (int it = gw; it < NIT; it += nw) {
        int r = it;
        if (r < IT_QKV) { tr_item(p.in[I_WQKV], 3072, 1024, (bf16_t*)(ws + WS_WQKV), p.in[I_MIXG], scr, r, lane, MapQKV{}); continue; } r -= IT_QKV;
        if (r < IT_SQ) { tr_item(p.in[I_WO], 1024, 1024, (bf16_t*)(ws + WS_WO), nullptr, scr, r, lane, MapId{0}); continue; } r -= IT_SQ;
        if (r < 2 * IT_W1) { const int l = r / IT_W1; tr_item(p.in[I_W1] + (size_t)l * 1024 * 4096, 4096, 1024, (bf16_t*)(ws + WS_W1 + l * 8 * MiB), p.in[I_MLPG] + l * 1024, scr, r % IT_W1, lane, MapId{0}); continue; } r -= 2 * IT_W1;
        if (r < 2 * IT_W2) { const int l = r / IT_W2; tr_item(p.in[I_W2] + (size_t)l * 1024 * 4096, 1024, 4096, (bf16_t*)(ws + WS_W2 + l * 8 * MiB), nullptr, scr, r % IT_W2, lane, MapId{0}); continue; } r -= 2 * IT_W2;
        if (r < IT_SQ) { tr_item(p.in[I_RWY], 1024, 1024, (bf16_t*)(ws + WS_WYX), p.in[I_MIXG] + 1024, scr, r, lane, MapId{0}); continue; } r -= IT_SQ;
        if (r < IT_SQ) { tr_item(p.in[I_RWX], 1024, 1024, (bf16_t*)(ws + WS_WYX), p.in[I_MIXG] + 1024, scr, r, lane, MapId{1024}); continue; } r -= IT_SQ;
        if (r < 8 * IT_G) { const int w = r / IT_G, grp = w & 3, isi = w >> 2;
            tr_item(p.in[isi ? I_RWI : I_RWA] + (size_t)grp * 65536, 256, 256, (bf16_t*)(ws + WS_WG), nullptr, scr, r % IT_G, lane, MapGate{grp * 512 + isi * 4}); continue; } r -= 8 * IT_G;
        tr_item(p.in[I_RWO], 1024, 1024, (bf16_t*)(ws + WS_WRO), nullptr, scr, r, lane, MapId{0});
    }
    float* par = (float*)(ws + WS_PAR);
    float* cosT = (float*)(ws + WS_ROPE); float* sinT = cosT + 4096 * 32;
    for (int e = gw * 64 + lane; e < 4096 * 32; e += nw * 64) { const int pos = e >> 5, i = e & 31; float s, c; sincos_d((double)pos * INV_FREQ[i], s, c); cosT[e] = c; sinT[e] = s; }
    for (int c = gw * 64 + lane; c < 1024; c += nw * 64) {
        const float x = -p.in[I_RLAM][c]; const float z = __expf(-fabsf(x));
        const float l1p = (z < 0.02f) ? z * (1.0f + z * (-0.5f + z * (0.33333333f + z * (-0.25f + z * 0.2f)))) : __logf(1.0f + z);
        par[256 + c] = 8.0f * (fmaxf(x, 0.f) + l1p);
    }
    if (gw == 0) { float a = p.in[I_LQ1][lane] * p.in[I_LK1][lane], b = p.in[I_LQ2][lane] * p.in[I_LK2][lane]; a = wave_sum(a); b = wave_sum(b);
        if (lane == 0) par[0] = expf(a) - expf(b) + LAMBDA_INIT; }
    bf16_t* XB = (bf16_t*)(ws + WS_XB); float* ssq0 = (float*)(ws + WS_SSQ);
    for (int m = gw; m < M; m += nw) {
        const f32x4* xr = (const f32x4*)(p.in[I_X] + (size_t)m * DM) + lane; float s = 0.f;
        u32x2* o8 = (u32x2*)(XB + (size_t)m * DM) + lane;
#pragma unroll
        for (int j = 0; j < 4; ++j) { const f32x4 v = xr[64 * j]; s += (v.x * v.x + v.y * v.y) + (v.z * v.z + v.w * v.w); u32x2 w; w.x = pk2(v.x, v.y); w.y = pk2(v.z, v.w); o8[64 * j] = w; }
        s = wave_sum(s); if (lane == 0) ssq0[m] = s;
    }
}

struct EpiQKV {
    const float* ssq; const float* cosT; const float* sinT; bf16_t* Q;
    struct Ctx { float rs; int pos; };
    __device__ __forceinline__ Ctx row(int r) const { Ctx c; c.rs = rsqrtf(ssq[r] * (1.0f / DM) + NORM_EPS); c.pos = r & (SEQ - 1); return c; }
    __device__ __forceinline__ float apply(const Ctx& c, int r, int c0, f32x4 lo, f32x4 hi) const {
        lo = lo * c.rs; hi = hi * c.rs;
        const int sec = c0 >> 10, cc = c0 & 1023;
        if (sec < 2) { const int g = (c0 & 63) >> 3; const f32x4 cs = *(const f32x4*)(cosT + c.pos * 32 + 4 * g), sn = *(const f32x4*)(sinT + c.pos * 32 + 4 * g);
            f32x4 nlo = lo * cs - hi * sn, nhi = hi * cs + lo * sn; if (sec == 0) { nlo = nlo * C2; nhi = nhi * C2; } lo = nlo; hi = nhi; }
        *(u32x4*)(Q + (size_t)sec * ((size_t)M * DM) + (size_t)r * DM + cc) = pk8(lo, hi);
        return 0.f;
    }
    __device__ __forceinline__ void row_end(int, float) const {}
    static constexpr bool HAS_ROW_END = false;
};
struct EpiRes {
    const float* xin; float* xout; bf16_t* XB; float* ssq;
    struct Ctx { int dummy; };
    __device__ __forceinline__ Ctx row(int) const { return Ctx{0}; }
    __device__ __forceinline__ float apply(const Ctx&, int r, int c0, f32x4 lo, f32x4 hi) const {
        const size_t off = (size_t)r * DM + c0;
        const f32x4 a = *(const f32x4*)(xin + off) + lo, b = *(const f32x4*)(xin + off + 4) + hi;
        *(f32x4*)(xout + off) = a; *(f32x4*)(xout + off + 4) = b;
        if (XB) *(u32x4*)(XB + off) = pk8(a, b);
        return (a[0] * a[0] + a[1] * a[1]) + (a[2] * a[2] + a[3] * a[3]) + (b[0] * b[0] + b[1] * b[1]) + (b[2] * b[2] + b[3] * b[3]);
    }
    __device__ __forceinline__ void row_end(int r, float s) const { if (ssq) atomicAdd(ssq + r, s); }
    static constexpr bool HAS_ROW_END = true;
};
struct EpiUp {
    const float* ssq; bf16_t* H;
    struct Ctx { float rs; };
    __device__ __forceinline__ Ctx row(int r) const { return Ctx{rsqrtf(ssq[r] * (1.0f / DM) + NORM_EPS)}; }
    __device__ __forceinline__ float apply(const Ctx& c, int r, int c0, f32x4 lo, f32x4 hi) const {
        lo = lo * c.rs; hi = hi * c.rs;
#pragma unroll
        for (int j = 0; j < 4; ++j) { const float a = fmaxf(lo[j], 0.f), b = fmaxf(hi[j], 0.f); lo[j] = a * a; hi[j] = b * b; }
        *(u32x4*)(H + (size_t)r * FF + c0) = pk8(lo, hi); return 0.f;
    }
    __device__ __forceinline__ void row_end(int, float) const {}
    static constexpr bool HAS_ROW_END = false;
};
struct EpiRecIn {
    const float* ssq; bf16_t* Y; bf16_t* XP;
    struct Ctx { float rs; };
    __device__ __forceinline__ Ctx row(int r) const { return Ctx{rsqrtf(ssq[r] * (1.0f / DM) + NORM_EPS)}; }
    __device__ __forceinline__ float apply(const Ctx& c, int r, int c0, f32x4 lo, f32x4 hi) const {
        lo = lo * c.rs; hi = hi * c.rs;
        if (c0 < 1024) {
#pragma unroll
            for (int j = 0; j < 4; ++j) { lo[j] = gelu_tanh(lo[j]); hi[j] = gelu_tanh(hi[j]); }
            *(u32x4*)(Y + (size_t)r * DM + c0) = pk8(lo, hi);
        } else *(u32x4*)(XP + (size_t)r * DM + (c0 - 1024)) = pk8(lo, hi);
        return 0.f;
    }
    __device__ __forceinline__ void row_end(int, float) const {}
    static constexpr bool HAS_ROW_END = false;
};
struct EpiGates {
    const float* ba; const float* bi; const float* sp8; const bf16_t* XC; bf16_t* LAU;
    struct Ctx { int dummy; };
    __device__ __forceinline__ Ctx row(int) const { return Ctx{0}; }
    __device__ __forceinline__ float apply(const Ctx&, int r, int c0, f32x4 lo, f32x4 hi) const {
        const int grp = c0 >> 9, q = (c0 & 511) >> 3, ch = grp * 256 + 4 * q;
        const f32x4 b_a = *(const f32x4*)(ba + ch), b_i = *(const f32x4*)(bi + ch), sp = *(const f32x4*)(sp8 + ch);
        const u32x2 xw = *(const u32x2*)(XC + (size_t)r * DM + ch);
        const float xc[4] = {bf2f(xw.x & 0xffffu), bf2f(xw.x >> 16), bf2f(xw.y & 0xffffu), bf2f(xw.y >> 16)};
        unsigned w[4];
#pragma unroll
        for (int j = 0; j < 4; ++j) {
            const float rg = sigmoidf_(lo[j] + b_a[j]), ig = sigmoidf_(hi[j] + b_i[j]);
            const float la = -rg * sp[j];
            const float t = 2.0f * la;
            const float om = (t > -0.05f) ? -t * (1.0f + t * (0.5f + t * (0.16666667f + t * 0.041666668f))) : 1.0f - __expf(t);
            const float u = sqrtf(fmaxf(om, 0.f)) * ig * xc[j];
            w[j] = pk2(la, u);
        }
        u32x4 o; o.x = w[0]; o.y = w[1]; o.z = w[2]; o.w = w[3];
        *(u32x4*)(LAU + ((size_t)r * DM + ch) * 2) = o; return 0.f;
    }
    __device__ __forceinline__ void row_end(int, float) const {}
    static constexpr bool HAS_ROW_END = false;
};

__global__ void __launch_bounds__(256) k_prologue(Params p) {
    __shared__ float scr[4][64 * 33];
    const int lane = threadIdx.x & 63, wave = threadIdx.x >> 6;
    prologue_work(p, blockIdx.x * 4 + wave, gridDim.x * 4, lane, (LAS float*)&scr[wave][0]);
}

template <class Epi>
__global__ void __launch_bounds__(256) k_gemm_naive(const bf16_t* A, int lda, const bf16_t* Bt, int ldb, int K, int agrp, Epi epi) {
    __shared__ float As[32][68]; __shared__ float Bs[32][132];
    const int tid = threadIdx.x, tx = tid & 15, ty = tid >> 4;
    const int n0 = blockIdx.x * 128, m0 = blockIdx.y * 64;
    const int acol = agrp ? (n0 >> 9) * 256 : 0;
    float acc[4][8];
#pragma unroll
    for (int i = 0; i < 4; ++i)
#pragma unroll
        for (int j = 0; j < 8; ++j) acc[i][j] = 0.f;
    for (int k0 = 0; k0 < K; k0 += 32) {
        { const int row = tid >> 2, kc = (tid & 3) * 8; float f[8]; unpk8(*(const u32x4*)(A + (size_t)(m0 + row) * lda + acol + k0 + kc), f);
#pragma unroll
          for (int e = 0; e < 8; ++e) As[kc + e][row] = f[e]; }
#pragma unroll
        for (int j = 0; j < 2; ++j) { const int idx = tid + 256 * j, row = idx >> 2, kc = (idx & 3) * 8; float f[8]; unpk8(*(const u32x4*)(Bt + (size_t)(n0 + row) * ldb + k0 + kc), f);
#pragma unroll
          for (int e = 0; e < 8; ++e) Bs[kc + e][row] = f[e]; }
        __syncthreads();
#pragma unroll 4
        for (int k = 0; k < 32; ++k) {
            const f32x4 a = *(const f32x4*)&As[k][ty * 4]; const f32x4 b0 = *(const f32x4*)&Bs[k][tx * 8], b1 = *(const f32x4*)&Bs[k][tx * 8 + 4];
#pragma unroll
            for (int i = 0; i < 4; ++i) {
#pragma unroll
                for (int j = 0; j < 4; ++j) { acc[i][j] += a[i] * b0[j]; acc[i][4 + j] += a[i] * b1[j]; } }
        }
        __syncthreads();
    }
#pragma unroll
    for (int i = 0; i < 4; ++i) { const int r = m0 + ty * 4 + i; const typename Epi::Ctx c = epi.row(r);
        const float s = epi.apply(c, r, n0 + tx * 8, (f32x4){acc[i][0], acc[i][1], acc[i][2], acc[i][3]}, (f32x4){acc[i][4], acc[i][5], acc[i][6], acc[i][7]});
        if (Epi::HAS_ROW_END) epi.row_end(r, s); }
}

constexpr int ATN_LDS = (64 * 129 * 2 + 64 * 128 + 2 * 64 * 65 + 256) * 4;
static_assert(ATN_LDS <= 135168, "simple attention scratch must stay below the LDS control words");
__global__ void __launch_bounds__(256) k_attn_naive(Params p) {
    extern __shared__ __attribute__((aligned(16))) float sm[];
    float* Qs = sm; float* Ks = Qs + 64 * 129; float* Vs = Ks + 64 * 129; float* Ss = Vs + 64 * 128; float* scl = Ss + 2 * 64 * 65; float* linv = scl + 128;
    const int tid = threadIdx.x;
    const int wg = blockIdx.x; const int qc = 63 - (wg >> 6), bh = wg & 63, b = bh >> 3, h = bh & 7;
    const bf16_t* Qg = (const bf16_t*)(p.ws + WS_Q); const bf16_t* Kg = (const bf16_t*)(p.ws + WS_K); const bf16_t* Vg = (const bf16_t*)(p.ws + WS_V);
    bf16_t* Og = (bf16_t*)(p.ws + WS_Q);
    const float lam = ((const float*)(p.ws + WS_PAR))[0];
    const size_t rowq = (size_t)b * SEQ + qc * 64;
#pragma unroll
    for (int i = 0; i < 4; ++i) { const int idx = tid + 256 * i, row = idx >> 4, pc = idx & 15; float f[8]; unpk8(*(const u32x4*)(Qg + (rowq + row) * DM + h * 128 + pc * 8), f);
#pragma unroll
        for (int e = 0; e < 8; ++e) Qs[row * 129 + pc * 8 + e] = f[e]; }
    const int r = tid >> 2, part = tid & 3;
    float o1[32], o2[32];
#pragma unroll
    for (int j = 0; j < 32; ++j) { o1[j] = 0.f; o2[j] = 0.f; }
    float mrun = -INFINITY, lrun = 0.f;
    for (int jt = 0; jt <= qc; ++jt) {
        const size_t rowk = (size_t)b * SEQ + jt * 64;
        __syncthreads();
#pragma unroll
        for (int i = 0; i < 4; ++i) { const int idx = tid + 256 * i, row = idx >> 4, pc = idx & 15; float f[8];
            unpk8(*(const u32x4*)(Kg + (rowk + row) * DM + h * 128 + pc * 8), f);
#pragma unroll
            for (int e = 0; e < 8; ++e) Ks[row * 129 + pc * 8 + e] = f[e];
            unpk8(*(const u32x4*)(Vg + (rowk + row) * DM + h * 128 + pc * 8), f);
#pragma unroll
            for (int e = 0; e < 8; ++e) Vs[row * 128 + pc * 8 + e] = f[e]; }
        __syncthreads();
#pragma unroll
        for (int c = 0; c < 2; ++c) {
            float acc[16];
#pragma unroll
            for (int kk = 0; kk < 16; ++kk) acc[kk] = 0.f;
            for (int d = 0; d < 64; ++d) { const float qv = Qs[r * 129 + c * 64 + d];
#pragma unroll
                for (int kk = 0; kk < 16; ++kk) acc[kk] += qv * Ks[(part * 16 + kk) * 129 + c * 64 + d]; }
#pragma unroll
            for (int kk = 0; kk < 16; ++kk) Ss[(c * 64 + r) * 65 + part * 16 + kk] = acc[kk];
        }
        __syncthreads();
        if (tid < 128) { float* s = Ss + tid * 65; float mx = -INFINITY;
            for (int k = 0; k < 64; ++k) mx = fmaxf(mx, s[k]);
            const float mn = fmaxf(mrun, mx), sc = exp2f(mrun - mn); float sum = 0.f;
            for (int k = 0; k < 64; ++k) { const float e = exp2f(s[k] - mn); s[k] = e; sum += e; }
            lrun = lrun * sc + sum; mrun = mn; scl[tid] = sc; }
        __syncthreads();
        { const float s1 = scl[r], s2 = scl[64 + r];
#pragma unroll
          for (int j = 0; j < 32; ++j) { o1[j] *= s1; o2[j] *= s2; }
          for (int k = 0; k < 64; ++k) { const float p1 = Ss[r * 65 + k], p2 = Ss[(64 + r) * 65 + k];
#pragma unroll
              for (int j4 = 0; j4 < 8; ++j4) { const f32x4 v = *(const f32x4*)&Vs[k * 128 + part * 32 + 4 * j4];
#pragma unroll
                  for (int e = 0; e < 4; ++e) { o1[4 * j4 + e] += p1 * v[e]; o2[4 * j4 + e] += p2 * v[e]; } } } }
    }
    __syncthreads();
    if (tid < 128) linv[tid] = 1.0f / lrun;
    __syncthreads();
    { const float i1 = linv[r], i2 = linv[64 + r] * lam; float ss = 0.f;
#pragma unroll
      for (int j = 0; j < 32; ++j) { o1[j] = o1[j] * i1 - o2[j] * i2; ss += o1[j] * o1[j]; }
      ss += __shfl_xor(ss, 1); ss += __shfl_xor(ss, 2);
      const float rn = rsqrtf(ss * (1.0f / 128.0f) + SUBLN_EPS) * (1.0f - LAMBDA_INIT);
      const float* g = p.in[I_SUBG] + part * 32;
      bf16_t* orow = Og + (rowq + r) * DM + h * 128 + part * 32;
#pragma unroll
      for (int j8 = 0; j8 < 4; ++j8) { f32x4 a, bq;
#pragma unroll
          for (int e = 0; e < 4; ++e) { a[e] = o1[8 * j8 + e] * rn * g[8 * j8 + e]; bq[e] = o1[8 * j8 + 4 + e] * rn * g[8 * j8 + 4 + e]; }
          *(u32x4*)(orow + 8 * j8) = pk8(a, bq); } }
}

__global__ void __launch_bounds__(256) k_conv(Params p) {
    const bf16_t* XP = (const bf16_t*)(p.ws + WS_XP); bf16_t* XC = (bf16_t*)(p.ws + WS_XC);
    const float* cw = p.in[I_CONVW]; const float* cb = p.in[I_CONVB];
    for (size_t i = (size_t)blockIdx.x * 256 + threadIdx.x; i < (size_t)M * 128; i += (size_t)gridDim.x * 256) {
        const int row = (int)(i >> 7), c = (int)(i & 127) * 8, t = row & (SEQ - 1);
        float acc[8];
#pragma unroll
        for (int e = 0; e < 8; ++e) acc[e] = cb[c + e];
#pragma unroll
        for (int j = 0; j < 4; ++j) { const int tt = t - 3 + j; if (tt >= 0) { float f[8]; unpk8(*(const u32x4*)(XP + (size_t)(row - 3 + j) * DM + c), f);
#pragma unroll
            for (int e = 0; e < 8; ++e) acc[e] += cw[j * DM + c + e] * f[e]; } }
        *(u32x4*)(XC + (size_t)row * DM + c) = pk8((f32x4){acc[0], acc[1], acc[2], acc[3]}, (f32x4){acc[4], acc[5], acc[6], acc[7]});
    }
}

__global__ void __launch_bounds__(256) k_scan_naive(Params p) {
    const unsigned* LAU = (const unsigned*)(p.ws + WS_LAU); bf16_t* Y = (bf16_t*)(p.ws + WS_Y);
    const int id = blockIdx.x * 256 + threadIdx.x; const int b = id >> 10, c = id & 1023;
    float h = 0.f;
    const size_t base = (size_t)b * SEQ * DM + c;
#pragma unroll 8
    for (int t = 0; t < SEQ; ++t) { const unsigned w = LAU[base + (size_t)t * DM]; const float la = bf2f(w & 0xffffu), u = bf2f(w >> 16);
        h = __expf(la) * h + u; const float y = bf2f(Y[base + (size_t)t * DM]); Y[base + (size_t)t * DM] = (bf16_t)f2bf(h * y); }
}

__global__ void __launch_bounds__(256) k_final_norm(Params p) {
    const int lane = threadIdx.x & 63; const int gw = blockIdx.x * 4 + (threadIdx.x >> 6), nw = gridDim.x * 4;
    const f32x4* g4 = (const f32x4*)p.in[I_FING] + lane;
    for (int m = gw; m < M; m += nw) { f32x4* xr = (f32x4*)(p.out + (size_t)m * DM) + lane; f32x4 v[4]; float s = 0.f;
#pragma unroll
        for (int j = 0; j < 4; ++j) { v[j] = xr[64 * j]; s += (v[j].x * v[j].x + v[j].y * v[j].y) + (v[j].z * v[j].z + v[j].w * v[j].w); }
        const float rs = rsqrtf(wave_sum(s) * (1.0f / DM) + NORM_EPS);
#pragma unroll
        for (int j = 0; j < 4; ++j) xr[64 * j] = v[j] * rs * g4[64 * j]; }
}


namespace pg8 {
#define PG8_LAS __attribute__((address_space(3)))
typedef short bf16x8 __attribute__((ext_vector_type(8)));
constexpr int BM = 256, BK = 64, HALF = 128, HTB = HALF * BK * 2  , STAGE_BYTES = 8 * HTB, NXCD = 8, WGM = 8;
__host__ __device__ __forceinline__ int lds_byte(int r, int c) { const int st = (r >> 4) * 2 + (c >> 5), rr = r & 15, cc = c & 31, ob = rr * 64 + cc * 2; return st * 1024 + (ob ^ (((ob >> 9) & 1) << 5)); }
__host__ __device__ __forceinline__ void stage_rc(int b, int& R, int& C) { const int st = b / 1024, sb = b % 1024, swz = sb ^ (((sb >> 9) & 1) << 5); R = (st >> 1) * 16 + swz / 64; C = (st & 1) * 32 + (swz % 64) / 2; }
__host__ __device__ __forceinline__ int perm32(int rho) { const int n = rho >> 4, i = rho & 15; return 8 * (i >> 2) + 4 * n + (i & 3); }
struct Unit { int pm, pn; };
struct Gemm { const bf16_t* A; const bf16_t* Bt; int M, N, K, lda, ldb, agrp; };
struct StaticOrder {
    int nM, nN, nwg, G, c;
    __host__ __device__ void init(int M, int N, int G_, int c_) { nM = M / BM; nN = N / BM; nwg = nM * nN; G = G_; c = c_; }
    __host__ __device__ bool next(int i, Unit& u) const {
        const long L = (long)i * G + c; if (L >= nwg) return false;
        int wgid = (int)L; { const int q = nwg / NXCD, r = nwg % NXCD, xcd = wgid % NXCD, off = wgid / NXCD; wgid = (xcd < r ? xcd * (q + 1) : r * (q + 1) + (xcd - r) * q) + off; }
        const int nig = WGM * nN, gid = wgid / nig, fm = gid * WGM, gsz = (nM - fm) < WGM ? (nM - fm) : WGM;
        u.pm = fm + ((wgid % nig) % gsz); u.pn = (wgid % nig) / gsz; return true;
    }
    __device__ __forceinline__ void a_ready(const Unit&) const {}
    __device__ __forceinline__ void done(const Unit&) const {}
};
template <class E8> struct EpiAdapt {
    static constexpr bool PERM = true, AFTER_DRAIN = false; E8 e;
    __device__ __forceinline__ void operator()(const f32x4 (&acc)[2][2][4][2], const Unit& u, int wr, int wc, int fr, int fq) const {
#pragma unroll
        for (int ai = 0; ai < 2; ++ai)
#pragma unroll
            for (int m = 0; m < 4; ++m) { const int row = u.pm * BM + ai * HALF + wr * 64 + m * 16 + fr; const typename E8::Ctx cx = e.row(row); float s = 0.f;
#pragma unroll
                for (int bj = 0; bj < 2; ++bj) s += e.apply(cx, row, u.pn * BM + bj * HALF + wc * 32 + 8 * fq, acc[ai][bj][m][0], acc[ai][bj][m][1]);
                if (E8::HAS_ROW_END) { s += __shfl_xor(s, 16); s += __shfl_xor(s, 32); if (fq == 0) e.row_end(row, s); } }
    }
};
template <class Epi, class Sched, bool ALIGN_EPI = false, bool SP2 = false>
__device__ __forceinline__ void gemm_phase(PG8_LAS unsigned char* lds, const Gemm g, const Sched& S, const Epi& E) {
    const int tid = threadIdx.x, wid = __builtin_amdgcn_readfirstlane(tid >> 6), lane = tid & 63, wr = wid >> 2, wc = wid & 3, fr = lane & 15, fq = lane >> 4;
    const int K = g.K, nt = K / BK;
    unsigned voffA[2], voffB[2];
#pragma unroll
    for (int i = 0; i < 2; ++i) { int R, C; stage_rc(tid * 16 + i * 8192, R, C); const int Rb = Epi::PERM ? ((R & ~31) + perm32(R & 31)) : R;
        voffA[i] = (unsigned)(R * g.lda + C) * 2u; voffB[i] = (unsigned)(Rb * g.ldb + C) * 2u; }
    const size_t kstep = (size_t)(BK * 2);
    const size_t hstepA = (size_t)HALF * g.lda * 2, hstepB = (size_t)HALF * g.ldb * 2;
    const size_t tstepA = 2 * hstepA, tstepB = 2 * hstepB;
#define PG8_ABASE(un) ((const char*)g.A + (size_t)(un).pm * tstepA + (g.agrp ? (size_t)((un).pn >> 1) * 512 : (size_t)0))
    const unsigned ldsw = (unsigned)wid * 1024u;
    const int aoff = lds_byte(wr * 64 + fr, fq * 8), boff = lds_byte(wc * 32 + fr, fq * 8);
#define PG8_SA(b, h) (((b) * 2 + (h)) * HTB)
#define PG8_SB(b, h) ((4 + (b) * 2 + (h)) * HTB)
#define PG8_STAGE(bufoff, gbase, voff) do { _Pragma("unroll") for (int _i = 0; _i < 2; ++_i) \
        __builtin_amdgcn_global_load_lds((const unsigned*)((const char*)(gbase) + (voff)[_i]), (PG8_LAS unsigned*)(lds + (bufoff) + ldsw + _i * 8192), 16, 0, 0); } while (0)
#define PG8_LDA(dst, b, h) do { _Pragma("unroll") for (int m = 0; m < 4; ++m) _Pragma("unroll") for (int k = 0; k < 2; ++k) dst[m][k] = *(const PG8_LAS bf16x8*)(lds + PG8_SA(b, h) + aoff + m * 2048 + k * 1024); } while (0)
#define PG8_LDB(dst, b, h) do { _Pragma("unroll") for (int n = 0; n < 2; ++n) _Pragma("unroll") for (int k = 0; k < 2; ++k) dst[n][k] = *(const PG8_LAS bf16x8*)(lds + PG8_SB(b, h) + boff + n * 2048 + k * 1024); } while (0)
#define PG8_MMA(ai, bj, At, Bt) do { __builtin_amdgcn_s_setprio(1); _Pragma("unroll") for (int m = 0; m < 4; ++m) _Pragma("unroll") for (int n = 0; n < 2; ++n) _Pragma("unroll") for (int k = 0; k < 2; ++k) \
        acc[ai][bj][m][n] = __builtin_amdgcn_mfma_f32_16x16x32_bf16(Bt[n][k], At[m][k], acc[ai][bj][m][n], 0, 0, 0); __builtin_amdgcn_s_setprio(0); } while (0)
#define PG8_WAIT_V(n) asm volatile("s_waitcnt vmcnt(" #n ")" ::: "memory")
#define PG8_WAIT_L(n) asm volatile("s_waitcnt lgkmcnt(" #n ")" ::: "memory")
#define PG8_BAR __builtin_amdgcn_s_barrier()
#define PG8_SCHED __builtin_amdgcn_sched_barrier(0)
    Unit cur, nxt; int ui = 0;
    if (!S.next(0, cur)) return;
    f32x4 acc[2][2][4][2];
#pragma unroll
    for (int a = 0; a < 2; ++a)
#pragma unroll
        for (int b = 0; b < 2; ++b)
#pragma unroll
            for (int m = 0; m < 4; ++m)
#pragma unroll
                for (int n = 0; n < 2; ++n) acc[a][b][m][n] = (f32x4){0.f, 0.f, 0.f, 0.f};
    bf16x8 At[4][2], B0[2][2], B1[2][2];
    const char* cA = PG8_ABASE(cur); const char* cB = (const char*)g.Bt + (size_t)cur.pn * tstepB;
    S.a_ready(cur);
    if constexpr (SP2) {
        PG8_STAGE(PG8_SB(0, 0), cB, voffB); PG8_STAGE(PG8_SB(0, 1), cB + hstepB, voffB); PG8_STAGE(PG8_SA(0, 0), cA, voffA); PG8_STAGE(PG8_SA(0, 1), cA + hstepA, voffA);
        if (wr == 1) PG8_BAR;
        PG8_WAIT_V(2); PG8_BAR;
        PG8_STAGE(PG8_SB(1, 0), cB + kstep, voffB); PG8_STAGE(PG8_SA(1, 0), cA + kstep, voffA); PG8_STAGE(PG8_SB(1, 1), cB + hstepB + kstep, voffB);
        PG8_WAIT_V(6); PG8_BAR;
    } else {
        PG8_STAGE(PG8_SB(0, 0), cB, voffB); PG8_STAGE(PG8_SA(0, 0), cA, voffA); PG8_STAGE(PG8_SB(0, 1), cB + hstepB, voffB); PG8_STAGE(PG8_SA(0, 1), cA + hstepA, voffA);
        if (wr == 1) PG8_BAR;
        PG8_WAIT_V(4); PG8_BAR;
        PG8_STAGE(PG8_SB(1, 0), cB + kstep, voffB); PG8_STAGE(PG8_SA(1, 0), cA + kstep, voffA); PG8_STAGE(PG8_SB(1, 1), cB + hstepB + kstep, voffB);
        PG8_WAIT_V(6); PG8_BAR;
    }
    for (;;) {
        const bool has_next = S.next(ui + 1, nxt);
        const char* nA = has_next ? PG8_ABASE(nxt) : cA; const char* nB = has_next ? (const char*)g.Bt + (size_t)nxt.pn * tstepB : cB;
        for (int t = 0; t < nt; t += 2) {
            const bool last = (t == nt - 2);
            const char* a1 = cA + (size_t)(t + 1) * kstep;
            const char* a2 = last ? nA : cA + (size_t)(t + 2) * kstep; const char* b2 = last ? nB : cB + (size_t)(t + 2) * kstep;
            const char* a3 = a2 + kstep; const char* b3 = b2 + kstep;
            if (last && has_next) S.a_ready(nxt);
            if constexpr (SP2) {
            PG8_LDB(B0, 0, 0); PG8_LDB(B1, 0, 1); PG8_SCHED; PG8_LDA(At, 0, 0); PG8_STAGE(PG8_SA(1, 1), a1 + hstepA, voffA);
            PG8_WAIT_V(8); PG8_WAIT_L(0); PG8_BAR; PG8_MMA(0, 0, At, B0); PG8_MMA(0, 1, At, B1); PG8_BAR; PG8_SCHED;
            PG8_LDA(At, 0, 1); PG8_STAGE(PG8_SB(0, 0), b2, voffB); PG8_STAGE(PG8_SB(0, 1), b2 + hstepB, voffB); PG8_STAGE(PG8_SA(0, 0), a2, voffA);
            PG8_WAIT_V(8); PG8_WAIT_L(0); PG8_BAR; PG8_MMA(1, 0, At, B0); PG8_MMA(1, 1, At, B1); PG8_BAR; PG8_SCHED;
            PG8_LDB(B0, 1, 0); PG8_LDB(B1, 1, 1); PG8_SCHED; PG8_LDA(At, 1, 0); PG8_STAGE(PG8_SA(0, 1), a2 + hstepA, voffA);
            PG8_WAIT_V(8); PG8_WAIT_L(0); PG8_BAR; PG8_MMA(0, 0, At, B0); PG8_MMA(0, 1, At, B1); PG8_BAR; PG8_SCHED;
            PG8_LDA(At, 1, 1); PG8_STAGE(PG8_SB(1, 0), b3, voffB); PG8_STAGE(PG8_SB(1, 1), b3 + hstepB, voffB); PG8_STAGE(PG8_SA(1, 0), a3, voffA);
            PG8_WAIT_V(8); PG8_WAIT_L(0); PG8_BAR; PG8_MMA(1, 0, At, B0); PG8_MMA(1, 1, At, B1); PG8_BAR; PG8_SCHED;
            } else {
            PG8_LDB(B0, 0, 0); PG8_SCHED; PG8_LDA(At, 0, 0); PG8_STAGE(PG8_SA(1, 1), a1 + hstepA, voffA);
            PG8_WAIT_L(8); PG8_BAR; PG8_WAIT_L(0); PG8_MMA(0, 0, At, B0); PG8_BAR; PG8_SCHED;
            PG8_LDB(B1, 0, 1); PG8_STAGE(PG8_SB(0, 0), b2, voffB);
            PG8_BAR; PG8_WAIT_L(0); PG8_MMA(0, 1, At, B1); PG8_BAR;
            PG8_LDA(At, 0, 1); PG8_STAGE(PG8_SA(0, 0), a2, voffA);
            PG8_BAR; PG8_WAIT_L(0); PG8_MMA(1, 0, At, B0); PG8_BAR; PG8_SCHED;
            PG8_STAGE(PG8_SB(0, 1), b2 + hstepB, voffB);
            PG8_WAIT_V(6); PG8_BAR; PG8_MMA(1, 1, At, B1); PG8_BAR;
            PG8_LDB(B0, 1, 0); PG8_SCHED; PG8_LDA(At, 1, 0); PG8_STAGE(PG8_SA(0, 1), a2 + hstepA, voffA);
            PG8_WAIT_L(8); PG8_BAR; PG8_WAIT_L(0); PG8_MMA(0, 0, At, B0); PG8_BAR; PG8_SCHED;
            PG8_LDB(B1, 1, 1); PG8_STAGE(PG8_SB(1, 0), b3, voffB);
            PG8_BAR; PG8_WAIT_L(0); PG8_MMA(0, 1, At, B1); PG8_BAR;
            PG8_LDA(At, 1, 1); PG8_STAGE(PG8_SA(1, 0), a3, voffA);
            PG8_BAR; PG8_WAIT_L(0); PG8_MMA(1, 0, At, B0); PG8_BAR; PG8_SCHED;
            PG8_STAGE(PG8_SB(1, 1), b3 + hstepB, voffB);
            PG8_WAIT_V(6); PG8_BAR; PG8_MMA(1, 1, At, B1); PG8_BAR;
            }
        }
        if constexpr (ALIGN_EPI) { if (wr == 0) PG8_BAR; }
        if constexpr (!Epi::AFTER_DRAIN) { E(acc, cur, wr, wc, fr, fq); S.done(cur); }
        if (!has_next) break;
#pragma unroll
        for (int a = 0; a < 2; ++a)
#pragma unroll
            for (int b = 0; b < 2; ++b)
#pragma unroll
                for (int m = 0; m < 4; ++m)
#pragma unroll
                    for (int n = 0; n < 2; ++n) acc[a][b][m][n] = (f32x4){0.f, 0.f, 0.f, 0.f};
        cur = nxt; cA = nA; cB = nB; ++ui;
        if constexpr (ALIGN_EPI) { if (wr == 1) PG8_BAR; }
    }
    PG8_WAIT_V(0);
    if constexpr (!ALIGN_EPI) { if (wr == 0) PG8_BAR; }
    PG8_BAR;
    if constexpr (Epi::AFTER_DRAIN) { E.fused(acc, cur, wr, wc, fr, fq, lds, wid, lane); S.done(cur); }
#undef PG8_SA
#undef PG8_SB
#undef PG8_STAGE
#undef PG8_LDA
#undef PG8_LDB
#undef PG8_MMA
#undef PG8_WAIT_V
#undef PG8_WAIT_L
#undef PG8_BAR
#undef PG8_SCHED
#undef PG8_ABASE
}
}

constexpr int NWAVES = 8;
constexpr int RING_BYTES = 131072, LDSCTL_OFF = 135168, MISC_OFF = LDSCTL_OFF + 320, LDS_BYTES = 147456;
constexpr int CW_BAR = 4096;
constexpr int NPH = 14;
#define GAS __attribute__((address_space(1)))
typedef GAS unsigned gu32;
#define RLX_AGENT __ATOMIC_RELAXED, __HIP_MEMORY_SCOPE_AGENT
#define XB_TMO      128
#define XB_XCNT(j)  (256  + 64 * (j))
#define XB_XSUB(j)  (1280 + 64 * (j))
#define XB_XGEN(j)  (2304 + 64 * (j))
#define XB_TOP      3328
#define XB_TOPGEN   3392
#define XCD_BAR_WORDS 3456
#define XB_SPIN_CAP (1u << 18)

__device__ __forceinline__ unsigned xb_ld(unsigned* p)              { return __hip_atomic_load(p, __ATOMIC_RELAXED, __HIP_MEMORY_SCOPE_AGENT); }
__device__ __forceinline__ unsigned xb_add(unsigned* p, unsigned v) { return __hip_atomic_fetch_add(p, v, __ATOMIC_RELAXED, __HIP_MEMORY_SCOPE_AGENT); }
__device__ __forceinline__ unsigned xb_xcc_id() { return (unsigned)__builtin_amdgcn_s_getreg((3 << 11) | 20) & 0xFu; }
#define XB_SPIN(cond, bar) do { unsigned _sp = 0; while (cond) { __builtin_amdgcn_s_sleep(1); \
    if ((++_sp & 255u) == 0u) { if (xb_ld(&(bar)[XB_TMO])) break; if (_sp > XB_SPIN_CAP) { atomicAdd(&(bar)[XB_TMO], 1u); break; } } } } while (0)

struct XcdBarrier {
    unsigned* bar; unsigned x;
    volatile LAS unsigned* st;
};

__device__ __forceinline__ XcdBarrier xcd_barrier_post(unsigned* bar, volatile LAS unsigned* st) {
    XcdBarrier b; b.bar = bar; b.x = xb_xcc_id(); b.st = st;
    if (threadIdx.x == 0) (void)xb_add(&bar[XB_XCNT(b.x)], 1u);
    return b;
}
__device__ __forceinline__ void xcd_barrier_complete(unsigned* bar, unsigned x, unsigned& nloc, unsigned& nx) {
    const unsigned G = gridDim.x * gridDim.y * gridDim.z;
    unsigned sum, cnt, mine, sp = 0u;
    for (;;) {
        sum = 0u; cnt = 0u; mine = 0u;
#pragma unroll
        for (unsigned j = 0; j < 16; ++j) { const unsigned c = xb_ld(&bar[XB_XCNT(j)]); sum += c; cnt += (c > 0u) ? 1u : 0u; mine = (j == x) ? c : mine; }
        if (sum == G) break;
        __builtin_amdgcn_s_sleep(1);
        if ((++sp & 255u) == 0u) { if (xb_ld(&bar[XB_TMO])) break; if (sp > XB_SPIN_CAP) { atomicAdd(&bar[XB_TMO], 1u); break; } }
    }
    nloc = mine > 0u ? mine : 1u; nx = cnt > 0u ? cnt : 1u;
}

__device__ __forceinline__ void xcd_barrier(const XcdBarrier& b) {
    asm volatile("s_waitcnt vmcnt(0)" ::: "memory");
    __syncthreads();
    if (threadIdx.x == 0) {
        unsigned* bar = b.bar;
        __builtin_amdgcn_s_waitcnt(0);
        unsigned nloc = b.st[0], nx = b.st[1];
        if (nloc == 0u) { xcd_barrier_complete(bar, b.x, nloc, nx); b.st[0] = nloc; b.st[1] = nx; }
        const unsigned old = xb_add(&bar[XB_XSUB(b.x)], 1u);
        const unsigned gen = old / nloc;
        if (old + 1u == (gen + 1u) * nloc) {
            __builtin_amdgcn_fence(__ATOMIC_RELEASE, "agent");
            asm volatile("s_waitcnt vmcnt(0)" ::: "memory");
            const unsigned og = xb_add(&bar[XB_TOP], 1u);
            const unsigned tg = og / nx;
            if (og + 1u == (tg + 1u) * nx) xb_add(&bar[XB_TOPGEN], 1u);
            else XB_SPIN(xb_ld(&bar[XB_TOPGEN]) == tg, bar);
            __builtin_amdgcn_fence(__ATOMIC_ACQUIRE, "agent");
            xb_add(&bar[XB_XGEN(b.x)], 1u);
            asm volatile("s_waitcnt vmcnt(0)" ::: "memory");
        } else {
            XB_SPIN(xb_ld(&bar[XB_XGEN(b.x)]) == gen, bar);
            __builtin_amdgcn_fence(__ATOMIC_ACQUIRE, "agent");
            asm volatile("s_waitcnt vmcnt(0)" ::: "memory");
        }
    }
    __syncthreads();
}


namespace attn {
using bf16x8 = __attribute__((ext_vector_type(8))) short;
using s16x4 = __attribute__((ext_vector_type(4))) short;
using f32x16 = __attribute__((ext_vector_type(16))) float;
typedef short v4i16_t __attribute__((ext_vector_type(4)));
typedef __attribute__((address_space(3))) const char* lds_cptr;
constexpr int SLOTB = 16384, NSLOT = 3;
constexpr int LDS_K = 0, LDS_V = NSLOT * SLOTB, LDS_WS = 2 * NSLOT * SLOTB, LDS_END = LDS_WS + 8 * 256;
constexpr int STG_ROW = 132;
#ifndef ATTN_THR
#define ATTN_THR 8
#endif
__device__ __forceinline__ int crow(int r, int hi) { return (r & 3) + 8 * (r >> 2) + 4 * hi; }
#define SBAR() __builtin_amdgcn_sched_barrier(0)
#define WAIT_BAR(N) asm volatile("s_waitcnt vmcnt(" #N ") lgkmcnt(0)\n\ts_barrier" ::: "memory")
__device__ __forceinline__ void glds16(const void* gsrc, unsigned lds_dst) { unsigned keep;
    asm volatile("s_mov_b32 %0, m0\n\ts_mov_b32 m0, %2\n\ts_nop 0\n\tglobal_load_lds_dwordx4 %1, off\n\ts_mov_b32 m0, %0" : "=&s"(keep) : "v"(gsrc), "s"(lds_dst) : "memory"); }
typedef float f32x2_t __attribute__((ext_vector_type(2))); typedef __bf16 bf16x2_t __attribute__((ext_vector_type(2)));
__device__ __forceinline__ unsigned cvtpk(float lo, float hi) { f32x2_t v = {lo, hi}; bf16x2_t b = __builtin_convertvector(v, bf16x2_t); return __builtin_bit_cast(unsigned, b); }
__device__ __forceinline__ s16x4 vtr(lds_cptr p) { return __builtin_bit_cast(s16x4, __builtin_amdgcn_ds_read_tr16_b64_v4i16((__attribute__((address_space(3))) v4i16_t*)p)); }
__device__ __forceinline__ bf16x8 ldk(lds_cptr p) { return *(const __attribute__((address_space(3))) bf16x8*)p; }
__device__ __forceinline__ float swapmax(float m) { auto rr = __builtin_amdgcn_permlane32_swap(__float_as_uint(m), __float_as_uint(m), false, false); return __builtin_fmaxf(__uint_as_float(rr[0]), __uint_as_float(rr[1])); }
__device__ __forceinline__ float swapsum(float m) { auto rr = __builtin_amdgcn_permlane32_swap(__float_as_uint(m), __float_as_uint(m), false, false); return __uint_as_float(rr[0]) + __uint_as_float(rr[1]); }

__device__ __forceinline__ void attn_unit(int b, int h, int j, const bf16_t* Q, const bf16_t* __restrict__ K, const bf16_t* __restrict__ V, bf16_t* O, const float* subg, float lam, LAS unsigned char* shm) {
    const int tid = threadIdx.x, lane = tid & 63, r32 = lane & 31, hi = lane >> 5; const int wid = __builtin_amdgcn_readfirstlane(tid >> 6);
    const int rg = wid >> 1, c = wid & 1;
    const size_t rowbase = (size_t)b * SEQ; const int q0 = j * 128;
    const int NT = 2 * j + 2;
    const int NTW = 2 * j + 1 + (rg >> 1);
    const bf16_t* Qw = Q + (rowbase + q0 + rg * 32) * DM + h * 128 + c * 64;
    const char* Kh = (const char*)(K + rowbase * DM + h * 128); const char* Vh = (const char*)(V + rowbase * DM + h * 128);
    const unsigned lds0 = (unsigned)(uintptr_t)shm;
    LAS float* wsf = (LAS float*)(shm + LDS_WS) + wid * 64;
    const char* ksrc[2]; const char* vsrc[2];
#pragma unroll
    for (int i = 0; i < 2; ++i) { const int p = 2 * wid + i, key = 4 * p + (lane >> 4), ch = (lane & 15) ^ (key & 15); ksrc[i] = Kh + (size_t)key * (DM * 2) + ch * 16;
        const int d0 = p >> 2, kg = p & 3, vkey = 16 * kg + (lane >> 2); vsrc[i] = Vh + (size_t)vkey * (DM * 2) + d0 * 64 + (lane & 3) * 16; }
    const unsigned kdst = lds0 + LDS_K + wid * 2048, vdst = lds0 + LDS_V + wid * 2048;
#define DMA_K(t, slot) do { glds16(ksrc[0] + (size_t)(t) * (64 * DM * 2), (unsigned)__builtin_amdgcn_readfirstlane(kdst + (slot))); glds16(ksrc[1] + (size_t)(t) * (64 * DM * 2), (unsigned)__builtin_amdgcn_readfirstlane(kdst + (slot) + 1024)); } while (0)
#define DMA_V(t, slot) do { glds16(vsrc[0] + (size_t)(t) * (64 * DM * 2), (unsigned)__builtin_amdgcn_readfirstlane(vdst + (slot))); glds16(vsrc[1] + (size_t)(t) * (64 * DM * 2), (unsigned)__builtin_amdgcn_readfirstlane(vdst + (slot) + 1024)); } while (0)
    const lds_cptr shm3 = (lds_cptr)shm;
    const int kch = ((8 * c + hi) ^ (r32 & 15)) * 16;
    const lds_cptr kp0 = shm3 + LDS_K + r32 * 256;
    const lds_cptr vp0 = shm3 + LDS_V + ((lane >> 4) & 1) * 32 + (lane & 3) * 8 + (4 * hi + ((lane & 15) >> 2)) * 64;
#define KFR(slot, kb, ks) ldk(kp0 + (slot) + (kb) * 8192 + (kch ^ ((ks) * 32)))
    DMA_K(0, 0); DMA_V(0, 0); DMA_K(1, SLOTB);
    bf16x8 qr[4];
#pragma unroll
    for (int ks = 0; ks < 4; ++ks) qr[ks] = *reinterpret_cast<const bf16x8*>(&Qw[(size_t)r32 * DM + ks * 16 + hi * 8]);
    if (2 < NT) DMA_K(2, 2 * SLOTB);
    float mhat = 0.f, l_reg = 0.f; f32x16 o[4];
#pragma unroll
    for (int d = 0; d < 4; ++d) o[d] = f32x16{};
    bool resc = false;
    f32x16 C0, C1;
    u32x4 pw0, pw1, pw2, pw3;
    bf16x8 kf[8];
    int sl_prev = 0, sl_cur = 0, sl_next = SLOTB;
#define ROT() do { sl_prev = sl_cur; sl_cur = sl_next; sl_next = (sl_next == (NSLOT - 1) * SLOTB) ? 0 : sl_next + SLOTB; } while (0)
#define RESC() do { if (resc) { asm volatile("s_waitcnt lgkmcnt(0)" ::: "memory"); \
        _Pragma("unroll") for (int d_ = 0; d_ < 4; ++d_) _Pragma("unroll") for (int r = 0; r < 16; ++r) o[d_][r] *= wsf[crow(r, hi)]; } } while (0)
#define PKW(P, B) cvtpk(P[B], P[B + 1])
#define PAF(k) __builtin_bit_cast(bf16x8, pw##k)
#define PIN(x) asm volatile("" : "+v"(x))
#define MX3(a, b, c) __builtin_fmaxf(__builtin_fmaxf((a), (b)), (c))
#define EX(v) __builtin_amdgcn_exp2f(v)
    WAIT_BAR(0);
    {
#pragma unroll
        for (int i = 0; i < 8; ++i) kf[i] = KFR(0, i >> 2, i & 3);
        C0 = f32x16{}; C1 = f32x16{};
#pragma unroll
        for (int ks = 0; ks < 4; ++ks) { C0 = __builtin_amdgcn_mfma_f32_32x32x16_bf16(kf[ks], qr[ks], C0, 0, 0, 0); C1 = __builtin_amdgcn_mfma_f32_32x32x16_bf16(kf[4 + ks], qr[ks], C1, 0, 0, 0); }
        float a = C0[0];
#pragma unroll
        for (int r = 1; r < 16; ++r) a = __builtin_fmaxf(a, C0[r]);
#pragma unroll
        for (int r = 0; r < 16; ++r) a = __builtin_fmaxf(a, C1[r]);
        const float rm = swapmax(a); mhat = rm; float sacc = 0.f;
#pragma unroll
        for (int r = 0; r < 16; ++r) { C0[r] = EX(C0[r] - rm); C1[r] = EX(C1[r] - rm); sacc += C0[r] + C1[r]; }
        l_reg = sacc;
        pw0 = (u32x4){PKW(C0, 0), PKW(C0, 2), PKW(C0, 4), PKW(C0, 6)}; pw1 = (u32x4){PKW(C0, 8), PKW(C0, 10), PKW(C0, 12), PKW(C0, 14)};
        pw2 = (u32x4){PKW(C1, 0), PKW(C1, 2), PKW(C1, 4), PKW(C1, 6)}; pw3 = (u32x4){PKW(C1, 8), PKW(C1, 10), PKW(C1, 12), PKW(C1, 14)};
    }
    WAIT_BAR(0);
    if (3 < NT) DMA_K(3, 0);
    DMA_V(1, SLOTB);
    ROT();
#pragma unroll
    for (int i = 0; i < 8; ++i) kf[i] = KFR(sl_cur, i >> 2, i & 3);
    WAIT_BAR(4);
    s16x4 vlo[8], vhi[8];
#define VFR(i) (bf16x8){vlo[i][0], vlo[i][1], vlo[i][2], vlo[i][3], vhi[i][0], vhi[i][1], vhi[i][2], vhi[i][3]}
#define VRD(i, d0) do { vlo[i] = vtr(vp_ + ((d0) * 4096 + ((i) & 3) * 1024)); vhi[i] = vtr(vp_ + ((d0) * 4096 + ((i) & 3) * 1024 + 512)); } while (0)
#define GAPA(MF, i, d0) do { VRD(i, d0); SBAR(); MF; SBAR(); } while (0)
#define GAPB(MF, X, B, PWN, W) do { MF; X[B] = EX(X[B]); X[B + 1] = EX(X[B + 1]); sacc += X[B]; sacc += X[B + 1]; PWN[W] = PKW(X, B); PIN(sacc); PIN(PWN); SBAR(); } while (0)
#define KRD(G, i) do { if (G) { kf[i] = KFR(sl_next, (i) >> 2, (i) & 3); SBAR(); } } while (0)
#define STEP(t, GK, GV, GL) do { SBAR(); \
    const lds_cptr vp_ = vp0 + sl_prev; u32x4 pn0, pn1, pn2, pn3; \
    { const float nm_ = -mhat; _Pragma("unroll") for (int r = 0; r < 16; ++r) { C0[r] = nm_; C1[r] = nm_; } } \
    GAPA(C0 = __builtin_amdgcn_mfma_f32_32x32x16_bf16(kf[0], qr[0], C0, 0, 0, 0), 0, 0); \
    GAPA(C1 = __builtin_amdgcn_mfma_f32_32x32x16_bf16(kf[4], qr[0], C1, 0, 0, 0), 4, 1); \
    GAPA(C0 = __builtin_amdgcn_mfma_f32_32x32x16_bf16(kf[1], qr[1], C0, 0, 0, 0), 1, 0); \
    GAPA(C1 = __builtin_amdgcn_mfma_f32_32x32x16_bf16(kf[5], qr[1], C1, 0, 0, 0), 5, 1); \
    GAPA(C0 = __builtin_amdgcn_mfma_f32_32x32x16_bf16(kf[2], qr[2], C0, 0, 0, 0), 2, 0); \
    GAPA(C1 = __builtin_amdgcn_mfma_f32_32x32x16_bf16(kf[6], qr[2], C1, 0, 0, 0), 6, 1); \
    GAPA(C0 = __builtin_amdgcn_mfma_f32_32x32x16_bf16(kf[3], qr[3], C0, 0, 0, 0), 3, 0); \
    GAPA(C1 = __builtin_amdgcn_mfma_f32_32x32x16_bf16(kf[7], qr[3], C1, 0, 0, 0), 7, 1); \
    if (GK) { DMA_K((t) + 3, sl_cur); } if (GV) { DMA_V((t) + 1, sl_next); } \
    { float a = MX3(C0[0], C0[1], C1[0]), b2 = MX3(C0[2], C0[3], C1[1]); a = MX3(a, C1[2], C1[3]); \
      _Pragma("unroll") for (int r = 4; r < 16; r += 4) { a = MX3(a, C0[r], C0[r + 1]); b2 = MX3(b2, C0[r + 2], C0[r + 3]); a = MX3(a, C1[r], C1[r + 1]); b2 = MX3(b2, C1[r + 2], C1[r + 3]); } \
      const float rm = swapmax(__builtin_fmaxf(a, b2)); \
      resc = false; \
      if (__builtin_expect(__any(rm > (float)ATTN_THR), 0)) { const float dl = __builtin_fmaxf(rm, 0.f); mhat += dl; \
        _Pragma("unroll") for (int r = 0; r < 16; ++r) { C0[r] -= dl; C1[r] -= dl; } \
        const float f = __builtin_amdgcn_exp2f(-dl); l_reg *= f; if (hi == 0) wsf[r32] = f; resc = true; } } \
    float sacc = 0.f; \
    SBAR(); \
    GAPB(o[0] = __builtin_amdgcn_mfma_f32_32x32x16_bf16(PAF(0), VFR(0), o[0], 0, 0, 0), C0, 0, pn0, 0);  VRD(0, 2); SBAR(); \
    GAPB(o[1] = __builtin_amdgcn_mfma_f32_32x32x16_bf16(PAF(0), VFR(4), o[1], 0, 0, 0), C0, 2, pn0, 1);  VRD(4, 3); SBAR(); \
    GAPB(o[0] = __builtin_amdgcn_mfma_f32_32x32x16_bf16(PAF(1), VFR(1), o[0], 0, 0, 0), C0, 4, pn0, 2);  VRD(1, 2); SBAR(); \
    GAPB(o[1] = __builtin_amdgcn_mfma_f32_32x32x16_bf16(PAF(1), VFR(5), o[1], 0, 0, 0), C0, 6, pn0, 3);  VRD(5, 3); SBAR(); \
    GAPB(o[0] = __builtin_amdgcn_mfma_f32_32x32x16_bf16(PAF(2), VFR(2), o[0], 0, 0, 0), C0, 8, pn1, 0);  VRD(2, 2); SBAR(); \
    GAPB(o[1] = __builtin_amdgcn_mfma_f32_32x32x16_bf16(PAF(2), VFR(6), o[1], 0, 0, 0), C0, 10, pn1, 1); VRD(6, 3); SBAR(); \
    GAPB(o[0] = __builtin_amdgcn_mfma_f32_32x32x16_bf16(PAF(3), VFR(3), o[0], 0, 0, 0), C0, 12, pn1, 2); VRD(3, 2); SBAR(); \
    GAPB(o[1] = __builtin_amdgcn_mfma_f32_32x32x16_bf16(PAF(3), VFR(7), o[1], 0, 0, 0), C0, 14, pn1, 3); VRD(7, 3); SBAR(); \
    KRD(GL, 0); GAPB(o[2] = __builtin_amdgcn_mfma_f32_32x32x16_bf16(PAF(0), VFR(0), o[2], 0, 0, 0), C1, 0, pn2, 0); \
    KRD(GL, 1); GAPB(o[3] = __builtin_amdgcn_mfma_f32_32x32x16_bf16(PAF(0), VFR(4), o[3], 0, 0, 0), C1, 2, pn2, 1); \
    KRD(GL, 2); GAPB(o[2] = __builtin_amdgcn_mfma_f32_32x32x16_bf16(PAF(1), VFR(1), o[2], 0, 0, 0), C1, 4, pn2, 2); \
    KRD(GL, 3); GAPB(o[3] = __builtin_amdgcn_mfma_f32_32x32x16_bf16(PAF(1), VFR(5), o[3], 0, 0, 0), C1, 6, pn2, 3); \
    KRD(GL, 4); GAPB(o[2] = __builtin_amdgcn_mfma_f32_32x32x16_bf16(PAF(2), VFR(2), o[2], 0, 0, 0), C1, 8, pn3, 0); \
    KRD(GL, 5); GAPB(o[3] = __builtin_amdgcn_mfma_f32_32x32x16_bf16(PAF(2), VFR(6), o[3], 0, 0, 0), C1, 10, pn3, 1); \
    KRD(GL, 6); GAPB(o[2] = __builtin_amdgcn_mfma_f32_32x32x16_bf16(PAF(3), VFR(3), o[2], 0, 0, 0), C1, 12, pn3, 2); \
    KRD(GL, 7); GAPB(o[3] = __builtin_amdgcn_mfma_f32_32x32x16_bf16(PAF(3), VFR(7), o[3], 0, 0, 0), C1, 14, pn3, 3); \
    l_reg += sacc; pw0 = pn0; pw1 = pn1; pw2 = pn2; pw3 = pn3; \
    } while (0)
#define DRAIN(slot) do { const lds_cptr vp_ = vp0 + (slot); \
    _Pragma("unroll") for (int dd = 0; dd < 4; dd += 2) { \
      _Pragma("unroll") for (int i = 0; i < 8; ++i) VRD(i, dd + (i >> 2)); \
      o[dd] = __builtin_amdgcn_mfma_f32_32x32x16_bf16(PAF(0), VFR(0), o[dd], 0, 0, 0); o[dd + 1] = __builtin_amdgcn_mfma_f32_32x32x16_bf16(PAF(0), VFR(4), o[dd + 1], 0, 0, 0); \
      o[dd] = __builtin_amdgcn_mfma_f32_32x32x16_bf16(PAF(1), VFR(1), o[dd], 0, 0, 0); o[dd + 1] = __builtin_amdgcn_mfma_f32_32x32x16_bf16(PAF(1), VFR(5), o[dd + 1], 0, 0, 0); \
      o[dd] = __builtin_amdgcn_mfma_f32_32x32x16_bf16(PAF(2), VFR(2), o[dd], 0, 0, 0); o[dd + 1] = __builtin_amdgcn_mfma_f32_32x32x16_bf16(PAF(2), VFR(6), o[dd + 1], 0, 0, 0); \
      o[dd] = __builtin_amdgcn_mfma_f32_32x32x16_bf16(PAF(3), VFR(3), o[dd], 0, 0, 0); o[dd + 1] = __builtin_amdgcn_mfma_f32_32x32x16_bf16(PAF(3), VFR(7), o[dd + 1], 0, 0, 0); } \
    } while (0)
    int t = 1;
    for (; t + 3 < NT; ++t) { STEP(t, true, true, true); WAIT_BAR(4); RESC(); ROT(); }
    for (; t < NT - 1; ++t) { STEP(t, false, true, true); WAIT_BAR(0); RESC(); ROT(); }
    if (NTW == NT) { STEP(t, false, false, false); RESC(); DRAIN(sl_cur); }
    else DRAIN(sl_prev);
    l_reg = swapsum(l_reg);
    { const float fac = (c == 0 ? 1.0f : lam) / l_reg; if (hi == 0) wsf[32 + r32] = fac; }
    asm volatile("s_waitcnt lgkmcnt(0)" ::: "memory");
#pragma unroll
    for (int r = 0; r < 16; ++r) { const float f = wsf[32 + crow(r, hi)];
#pragma unroll
        for (int d = 0; d < 4; ++d) o[d][r] *= f; }
    WAIT_BAR(0);
    LAS float* stg = (LAS float*)shm + rg * (32 * STG_ROW);
    if (c == 1) {
#pragma unroll
        for (int d = 0; d < 4; ++d)
#pragma unroll
            for (int r = 0; r < 16; ++r) stg[crow(r, hi) * STG_ROW + d * 32 + r32] = o[d][r];
    }
    WAIT_BAR(0);
    if (c == 0) {
#pragma unroll
        for (int d = 0; d < 4; ++d)
#pragma unroll
            for (int r = 0; r < 16; ++r) { LAS float* a = stg + crow(r, hi) * STG_ROW + d * 32 + r32; *a = o[d][r] - *a; }
        asm volatile("s_waitcnt lgkmcnt(0)" ::: "memory");
        const int row = lane >> 1, half = lane & 1;
        const LAS f32x4* src = (const LAS f32x4*)(stg + row * STG_ROW + half * 64);
        f32x4 v[16]; float ss = 0.f;
#pragma unroll
        for (int i = 0; i < 16; ++i) { v[i] = src[i]; ss += (v[i].x * v[i].x + v[i].y * v[i].y) + (v[i].z * v[i].z + v[i].w * v[i].w); }
        ss += __shfl_xor(ss, 1);
        const float rn = rsqrtf(ss * (1.0f / 128.0f) + SUBLN_EPS) * (1.0f - LAMBDA_INIT);
        const f32x4* g4 = (const f32x4*)(subg + half * 64);
        bf16_t* orow = O + (rowbase + q0 + rg * 32 + row) * DM + h * 128 + half * 64;
#pragma unroll
        for (int i = 0; i < 8; ++i) { const f32x4 a = v[2 * i] * rn * g4[2 * i], bq = v[2 * i + 1] * rn * g4[2 * i + 1]; *(u32x4*)(orow + 8 * i) = pk8(a, bq); }
    }
    asm volatile("s_waitcnt vmcnt(0)" ::: "memory");
    WAIT_BAR(0);
#undef DMA_K
#undef DMA_V
#undef KFR
#undef ROT
#undef RESC
#undef PKW
#undef PAF
#undef VFR
#undef PIN
#undef MX3
#undef EX
#undef VRD
#undef GAPA
#undef GAPB
#undef KRD
#undef STEP
#undef DRAIN
}
#undef SBAR
#undef WAIT_BAR
__device__ __forceinline__ void attn_phase(const Params& p, LAS unsigned char* lds, int vcu) {
    const bf16_t* Q = (const bf16_t*)(p.ws + WS_Q); const bf16_t* K = (const bf16_t*)(p.ws + WS_K); const bf16_t* V = (const bf16_t*)(p.ws + WS_V);
    const float lam = ((const float*)(p.ws + WS_PAR))[0];
    const int bh = vcu >> 2, qq = vcu & 3;
    for (int i = 0; i < 8; ++i) { const int s = qq + 4 * (i >> 1); const int j = (i & 1) ? 31 - s : s;
        attn_unit(bh >> 3, bh & 7, j, Q, K, V, (bf16_t*)(p.ws + WS_Q), p.in[I_SUBG], lam, lds); }
}
}

__device__ __forceinline__ void attn_simple_unit(const Params& p, LAS float* sm, int wg) {
    LAS float* Qs = sm; LAS float* Ks = Qs + 64 * 129; LAS float* Vs = Ks + 64 * 129; LAS float* Ss = Vs + 64 * 128; LAS float* scl = Ss + 2 * 64 * 65; LAS float* linv = scl + 128;
    const int tid = threadIdx.x;
    const int qc = 63 - (wg >> 6), bh = wg & 63, b = bh >> 3, h = bh & 7;
    const bf16_t* Qg = (const bf16_t*)(p.ws + WS_Q); const bf16_t* Kg = (const bf16_t*)(p.ws + WS_K); const bf16_t* Vg = (const bf16_t*)(p.ws + WS_V);
    bf16_t* Og = (bf16_t*)(p.ws + WS_Q);
    const float lam = ((const float*)(p.ws + WS_PAR))[0];
    const size_t rowq = (size_t)b * SEQ + qc * 64;
    __syncthreads();
#pragma unroll
    for (int i = 0; i < 2; ++i) { const int idx = tid + 512 * i, row = idx >> 4, pc = idx & 15; float f[8]; unpk8(*(const u32x4*)(Qg + (rowq + row) * DM + h * 128 + pc * 8), f);
#pragma unroll
        for (int e = 0; e < 8; ++e) Qs[row * 129 + pc * 8 + e] = f[e]; }
    const int r = tid >> 3, part = tid & 7;
    float o1[16], o2[16];
#pragma unroll
    for (int j = 0; j < 16; ++j) { o1[j] = 0.f; o2[j] = 0.f; }
    float mrun = -INFINITY, lrun = 0.f;
    for (int jt = 0; jt <= qc; ++jt) {
        const size_t rowk = (size_t)b * SEQ + jt * 64;
        __syncthreads();
#pragma unroll
        for (int i = 0; i < 2; ++i) { const int idx = tid + 512 * i, row = idx >> 4, pc = idx & 15; float f[8];
            unpk8(*(const u32x4*)(Kg + (rowk + row) * DM + h * 128 + pc * 8), f);
#pragma unroll
            for (int e = 0; e < 8; ++e) Ks[row * 129 + pc * 8 + e] = f[e];
            unpk8(*(const u32x4*)(Vg + (rowk + row) * DM + h * 128 + pc * 8), f);
#pragma unroll
            for (int e = 0; e < 8; ++e) Vs[row * 128 + pc * 8 + e] = f[e]; }
        __syncthreads();
#pragma unroll
        for (int c = 0; c < 2; ++c) {
            float acc[8];
#pragma unroll
            for (int kk = 0; kk < 8; ++kk) acc[kk] = 0.f;
            for (int d = 0; d < 64; ++d) { const float qv = Qs[r * 129 + c * 64 + d];
#pragma unroll
                for (int kk = 0; kk < 8; ++kk) acc[kk] += qv * Ks[(part * 8 + kk) * 129 + c * 64 + d]; }
#pragma unroll
            for (int kk = 0; kk < 8; ++kk) Ss[(c * 64 + r) * 65 + part * 8 + kk] = acc[kk];
        }
        __syncthreads();
        if (tid < 128) { LAS float* s = Ss + tid * 65; float mx = -INFINITY;
            for (int k = 0; k < 64; ++k) mx = fmaxf(mx, s[k]);
            const float mn = fmaxf(mrun, mx), sc = exp2f(mrun - mn); float sum = 0.f;
            for (int k = 0; k < 64; ++k) { const float e = exp2f(s[k] - mn); s[k] = e; sum += e; }
            lrun = lrun * sc + sum; mrun = mn; scl[tid] = sc; }
        __syncthreads();
        { const float s1 = scl[r], s2 = scl[64 + r];
#pragma unroll
          for (int j = 0; j < 16; ++j) { o1[j] *= s1; o2[j] *= s2; }
          for (int k = 0; k < 64; ++k) { const float p1 = Ss[r * 65 + k], p2 = Ss[(64 + r) * 65 + k];
#pragma unroll
              for (int j4 = 0; j4 < 4; ++j4) { const f32x4 v = *(const LAS f32x4*)&Vs[k * 128 + part * 16 + 4 * j4];
#pragma unroll
                  for (int e = 0; e < 4; ++e) { o1[4 * j4 + e] += p1 * v[e]; o2[4 * j4 + e] += p2 * v[e]; } } } }
    }
    __syncthreads();
    if (tid < 128) linv[tid] = 1.0f / lrun;
    __syncthreads();
    { const float i1 = linv[r], i2 = linv[64 + r] * lam; float ss = 0.f;
#pragma unroll
      for (int j = 0; j < 16; ++j) { o1[j] = o1[j] * i1 - o2[j] * i2; ss += o1[j] * o1[j]; }
      ss += __shfl_xor(ss, 1); ss += __shfl_xor(ss, 2); ss += __shfl_xor(ss, 4);
      const float rn = rsqrtf(ss * (1.0f / 128.0f) + SUBLN_EPS) * (1.0f - LAMBDA_INIT);
      const float* g = p.in[I_SUBG] + part * 16;
      bf16_t* orow = Og + (rowq + r) * DM + h * 128 + part * 16;
#pragma unroll
      for (int j8 = 0; j8 < 2; ++j8) { f32x4 a, bq;
#pragma unroll
          for (int e = 0; e < 4; ++e) { a[e] = o1[8 * j8 + e] * rn * g[8 * j8 + e]; bq[e] = o1[8 * j8 + 4 + e] * rn * g[8 * j8 + 4 + e]; }
          *(u32x4*)(orow + 8 * j8) = pk8(a, bq); } }
}
__device__ __forceinline__ void conv_phase(const Params& p, size_t gtid, size_t nthreads) {
    const bf16_t* XP = (const bf16_t*)(p.ws + WS_XP); bf16_t* XC = (bf16_t*)(p.ws + WS_XC);
    const float* cw = p.in[I_CONVW]; const float* cb = p.in[I_CONVB];
    for (size_t i = gtid; i < (size_t)M * 128; i += nthreads) {
        const int row = (int)(i >> 7), c = (int)(i & 127) * 8, t = row & (SEQ - 1);
        float acc[8];
#pragma unroll
        for (int e = 0; e < 8; ++e) acc[e] = cb[c + e];
#pragma unroll
        for (int j = 0; j < 4; ++j) { const int tt = t - 3 + j; if (tt >= 0) { float f[8]; unpk8(*(const u32x4*)(XP + (size_t)(row - 3 + j) * DM + c), f);
#pragma unroll
            for (int e = 0; e < 8; ++e) acc[e] += cw[j * DM + c + e] * f[e]; } }
        *(u32x4*)(XC + (size_t)row * DM + c) = pk8((f32x4){acc[0], acc[1], acc[2], acc[3]}, (f32x4){acc[4], acc[5], acc[6], acc[7]});
    }
}
__device__ __forceinline__ void scan_item(const Params& p, LAS float* sm, int item) {
    const unsigned* LAU = (const unsigned*)(p.ws + WS_LAU); bf16_t* Y = (bf16_t*)(p.ws + WS_Y);
    const int tid = threadIdx.x, seg = tid >> 5, ch = tid & 31; const int b = item >> 5, cb = item & 31;
    const size_t base = ((size_t)b * SEQ + (size_t)seg * 256) * DM + cb * 32 + ch;
    float h = 0.f, A = 0.f;
#pragma unroll 8
    for (int t = 0; t < 256; ++t) { const unsigned w = LAU[base + (size_t)t * DM]; const float la = bf2f(w & 0xffffu), u = bf2f(w >> 16); h = __expf(la) * h + u; A += la; }
    __syncthreads();
    sm[tid] = A; sm[512 + tid] = h;
    __syncthreads();
    float carry = 0.f;
    for (int s2 = 0; s2 < seg; ++s2) carry = __expf(sm[s2 * 32 + ch]) * carry + sm[512 + s2 * 32 + ch];
    h = carry;
#pragma unroll 8
    for (int t = 0; t < 256; ++t) { const unsigned w = LAU[base + (size_t)t * DM]; const float la = bf2f(w & 0xffffu), u = bf2f(w >> 16); h = __expf(la) * h + u;
        const float y = bf2f(Y[base + (size_t)t * DM]); Y[base + (size_t)t * DM] = (bf16_t)f2bf(h * y); }
}
__device__ __forceinline__ void final_norm_phase(const Params& p, int gw, int nw, int lane) {
    const f32x4* g4 = (const f32x4*)p.in[I_FING] + lane;
    for (int m = gw; m < M; m += nw) { f32x4* xr = (f32x4*)(p.out + (size_t)m * DM) + lane; f32x4 v[4]; float s = 0.f;
#pragma unroll
        for (int j = 0; j < 4; ++j) { v[j] = xr[64 * j]; s += (v[j].x * v[j].x + v[j].y * v[j].y) + (v[j].z * v[j].z + v[j].w * v[j].w); }
        const float rs = rsqrtf(wave_sum(s) * (1.0f / DM) + NORM_EPS);
#pragma unroll
        for (int j = 0; j < 4; ++j) xr[64 * j] = v[j] * rs * g4[64 * j]; }
}

struct Args { Params p; int ph_lo, ph_hi, li, pad; };
__global__ void __launch_bounds__(NWAVES * 64, 2) mega(Args a) {
    extern __shared__ __attribute__((aligned(16))) unsigned char lds_raw[];
    LAS unsigned char* lds = (LAS unsigned char*)lds_raw;
    volatile LAS unsigned* MISC = (volatile LAS unsigned*)(lds + MISC_OFF);
    const int tid = threadIdx.x, lane = tid & 63, wave = __builtin_amdgcn_readfirstlane(tid >> 6);
    const int G = gridDim.x; const int bx = blockIdx.x; const int vcu = (G % 8 == 0) ? (bx % 8) * (G / 8) + bx / 8 : bx;
    unsigned char* ws = a.p.ws;
    for (int u = tid; u < (LDS_BYTES - LDSCTL_OFF) / 4; u += NWAVES * 64) ((LAS unsigned*)(lds + LDSCTL_OFF))[u] = 0u;
    __syncthreads();
    XcdBarrier bar = xcd_barrier_post((unsigned*)(ws + WS_CTL) + CW_BAR + a.li * XCD_BAR_WORDS, MISC + 8);
    const int lo = a.ph_lo, hi = a.ph_hi;
#define IN(k) (lo <= (k) && (k) < hi)
#define SEAM(k) do { if (IN(k) && IN((k) + 1)) xcd_barrier(bar); } while (0)
    float* ssq = (float*)(ws + WS_SSQ); float* par = (float*)(ws + WS_PAR);
    const float* cosT = (const float*)(ws + WS_ROPE); const float* sinT = cosT + 4096 * 32;
    bf16_t* XB = (bf16_t*)(ws + WS_XB);
#define GEMM_PHASE(ET, EOBJ, AP, LDA, BP, LDB, NN, KK, AGRP) do { pg8::Gemm g{(const bf16_t*)(AP), (const bf16_t*)(BP), M, NN, KK, LDA, LDB, AGRP}; pg8::StaticOrder S; S.init(M, NN, G, bx); \
        pg8::EpiAdapt<ET> E{EOBJ}; pg8::gemm_phase<pg8::EpiAdapt<ET>, pg8::StaticOrder, true, true>(lds, g, S, E); } while (0)
    if (IN(0)) { prologue_work(a.p, vcu * NWAVES + wave, G * NWAVES, lane, (LAS float*)(lds + wave * 16384)); SEAM(0); }
    if (IN(1)) { GEMM_PHASE(EpiQKV, (EpiQKV{ssq, cosT, sinT, (bf16_t*)(ws + WS_Q)}), XB, DM, ws + WS_WQKV, DM, 3072, DM, 0); SEAM(1); }
#if defined(SIMPLE_ATTN)
    if (IN(2)) { for (int wg = bx; wg < 4096; wg += G) attn_simple_unit(a.p, (LAS float*)lds, wg); __syncthreads(); SEAM(2); }
#else
    if (IN(2)) { attn::attn_phase(a.p, lds, vcu); SEAM(2); }
#endif
    if (IN(3)) { GEMM_PHASE(EpiRes, (EpiRes{a.p.in[I_X], a.p.out, XB, ssq + M}), ws + WS_Q, DM, ws + WS_WO, DM, DM, DM, 0); SEAM(3); }
    if (IN(4)) { GEMM_PHASE(EpiUp, (EpiUp{ssq + M, (bf16_t*)(ws + WS_H)}), XB, DM, ws + WS_W1, DM, FF, DM, 0); SEAM(4); }
    if (IN(5)) { GEMM_PHASE(EpiRes, (EpiRes{a.p.out, a.p.out, XB, ssq + 2 * M}), ws + WS_H, FF, ws + WS_W2, FF, DM, FF, 0); SEAM(5); }
    if (IN(6)) { GEMM_PHASE(EpiRecIn, (EpiRecIn{ssq + 2 * M, (bf16_t*)(ws + WS_Y), (bf16_t*)(ws + WS_XP)}), XB, DM, ws + WS_WYX, DM, 2048, DM, 0); SEAM(6); }
    if (IN(7)) { conv_phase(a.p, (size_t)vcu * (NWAVES * 64) + tid, (size_t)G * (NWAVES * 64)); SEAM(7); }
    if (IN(8)) { GEMM_PHASE(EpiGates, (EpiGates{a.p.in[I_RBA], a.p.in[I_RBI], par + 256, (const bf16_t*)(ws + WS_XC), (bf16_t*)(ws + WS_LAU)}), ws + WS_XC, DM, ws + WS_WG, 256, 2048, 256, 1); SEAM(8); }
    if (IN(9)) { for (int it = bx; it < BATCH * 32; it += G) scan_item(a.p, (LAS float*)lds, it); __syncthreads(); SEAM(9); }
    if (IN(10)) { GEMM_PHASE(EpiRes, (EpiRes{a.p.out, a.p.out, XB, ssq + 3 * M}), ws + WS_Y, DM, ws + WS_WRO, DM, DM, DM, 0); SEAM(10); }
    if (IN(11)) { GEMM_PHASE(EpiUp, (EpiUp{ssq + 3 * M, (bf16_t*)(ws + WS_H)}), XB, DM, ws + WS_W1 + 8 * MiB, DM, FF, DM, 0); SEAM(11); }
    if (IN(12)) { GEMM_PHASE(EpiRes, (EpiRes{a.p.out, a.p.out, nullptr, nullptr}), ws + WS_H, FF, ws + WS_W2 + 8 * MiB, FF, DM, FF, 0); SEAM(12); }
    if (IN(13)) { final_norm_phase(a.p, vcu * NWAVES + wave, G * NWAVES, lane); }
#undef IN
#undef SEAM
#undef GEMM_PHASE
}

constexpr unsigned NAIVE_MASK = 0u;
extern "C" void kernel_launch(void* const* d_in, const int* in_sizes, int n_in, void* d_out, int out_size, void* d_ws, size_t ws_size, hipStream_t stream) {
    static int grid = 0;
    if (grid == 0) {
        if (n_in != 23 || in_sizes[0] != M * DM || out_size != M * DM || ws_size < WS_END) { fprintf(stderr, "kernel_launch: unexpected shapes (n_in %d, in0 %d, out %d, ws %zu)\n", n_in, n_in > 0 ? in_sizes[0] : -1, out_size, ws_size); grid = -1; return; }
        if (hipFuncSetAttribute((const void*)k_attn_naive, hipFuncAttributeMaxDynamicSharedMemorySize, ATN_LDS) != hipSuccess) { fprintf(stderr, "kernel_launch: hipFuncSetAttribute failed\n"); grid = -1; return; }
        if (hipFuncSetAttribute((const void*)mega, hipFuncAttributeMaxDynamicSharedMemorySize, LDS_BYTES) != hipSuccess) { fprintf(stderr, "kernel_launch: hipFuncSetAttribute(mega) failed\n"); grid = -1; return; }
        int dev = 0, cus = 0, per_cu = 0;
        if (hipGetDevice(&dev) != hipSuccess || hipDeviceGetAttribute(&cus, hipDeviceAttributeMultiprocessorCount, dev) != hipSuccess) { grid = -1; return; }
        if (hipOccupancyMaxActiveBlocksPerMultiprocessor(&per_cu, (const void*)mega, NWAVES * 64, LDS_BYTES) != hipSuccess || per_cu < 1) { fprintf(stderr, "kernel_launch: occupancy query says %d blocks per CU\n", per_cu); grid = -1; (void)hipGetLastError(); return; }
        grid = cus;
        if (grid != 256) fprintf(stderr, "kernel_launch: note: %d CUs\n", grid);
    }
    if (grid < 0) return;
    Args a{};
    for (int i = 0; i < 23; ++i) a.p.in[i] = (const float*)d_in[i];
    a.p.out = (float*)d_out; a.p.ws = (unsigned char*)d_ws;
    (void)hipMemsetAsync((unsigned char*)d_ws + WS_CTL, 0, CTL_ZERO_BYTES, stream);
    int li = 0;
    for (int ph = 0; ph < NPH;) {
        if (NAIVE_MASK & (1u << ph)) {
            if (ph == 2) k_attn_naive<<<4096, 256, ATN_LDS, stream>>>(a.p);
            else if (ph == 7) k_conv<<<2048, 256, 0, stream>>>(a.p);
            else if (ph == 9) k_scan_naive<<<BATCH * DM / 256, 256, 0, stream>>>(a.p);
            else if (ph == 13) k_final_norm<<<2048, 256, 0, stream>>>(a.p);
            ++ph; continue;
        }
        int e = ph; while (e < NPH && !(NAIVE_MASK & (1u << e))) ++e;
        a.ph_lo = ph; a.ph_hi = e; a.li = li++;
        hipLaunchKernelGGL(mega, dim3(grid), dim3(NWAVES * 64), LDS_BYTES, stream, a);
        ph = e;
    }
}
```

```cpp
#include <hip/hip_runtime.h>
#include <stdint.h>
#include <cstdio>

#define LAS __attribute__((address_space(3)))
typedef unsigned short bf16_t;
typedef float f32x4 __attribute__((ext_vector_type(4)));
typedef unsigned u32x4 __attribute__((ext_vector_type(4)));
typedef unsigned u32x2 __attribute__((ext_vector_type(2)));

#ifndef DUP_PHASE
#define DUP_PHASE (-1)
#endif
constexpr int BATCH = 8, SEQ = 4096, DM = 1024, FF = 4096, M = BATCH * SEQ;
constexpr int NH = 8;
constexpr float NORM_EPS = 1e-6f, SUBLN_EPS = 1e-5f;
constexpr float LAMBDA_INIT = 0.2f;
constexpr float C2 = 0.18033688011112042f;

constexpr size_t MiB = 1u << 20;
constexpr size_t WS_CTL = 0, CTL_ZERO_BYTES = 2 * MiB;
constexpr size_t WS_SSQ = 1 * MiB;
constexpr size_t WS_PAR = 2 * MiB;
constexpr size_t WS_ROPE = 3 * MiB;
constexpr size_t WS_WQKV = 4 * MiB, WS_WO = 10 * MiB, WS_W1 = 12 * MiB  , WS_W2 = 28 * MiB  , WS_WYX = 44 * MiB, WS_WG = 48 * MiB, WS_WRO = 49 * MiB;
constexpr size_t WS_XB = 52 * MiB;
constexpr size_t WS_R = 116 * MiB;
constexpr size_t WS_Q = WS_R, WS_K = WS_R + 64 * MiB, WS_V = WS_R + 128 * MiB, WS_O = WS_R + 192 * MiB, WS_H = WS_R;
constexpr size_t WS_Y = WS_R, WS_XC = WS_R + 64 * MiB, WS_XP = WS_R + 128 * MiB, WS_LAU = WS_R + 128 * MiB, WS_G = WS_XC;
constexpr size_t WS_END = WS_R + 256 * MiB;
constexpr size_t WS_DUMMY = WS_END;

struct Params { const float* in[23]; float* out; unsigned char* ws; };

enum { I_X = 0, I_MIXG, I_MLPG, I_WQKV, I_WO, I_LQ1, I_LK1, I_LQ2, I_LK2, I_SUBG, I_RWX, I_RWY, I_CONVW, I_CONVB, I_RWA, I_RBA, I_RWI, I_RBI, I_RLAM, I_RWO, I_W1, I_W2, I_FING };

__device__ __forceinline__ float bf2f(unsigned b) { return __uint_as_float(b << 16); }
__device__ __forceinline__ unsigned f2bf(float f) { unsigned u = __float_as_uint(f); return (u + 0x7fffu + ((u >> 16) & 1u)) >> 16; }
__device__ __forceinline__ unsigned pk2(float lo, float hi) { return f2bf(lo) | (f2bf(hi) << 16); }
__device__ __forceinline__ u32x4 pk8(f32x4 a, f32x4 b) { u32x4 w; w.x = pk2(a[0], a[1]); w.y = pk2(a[2], a[3]); w.z = pk2(b[0], b[1]); w.w = pk2(b[2], b[3]); return w; }
__device__ __forceinline__ void unpk8(u32x4 w, float* f) { f[0] = bf2f(w.x & 0xffffu); f[1] = bf2f(w.x >> 16); f[2] = bf2f(w.y & 0xffffu); f[3] = bf2f(w.y >> 16);
    f[4] = bf2f(w.z & 0xffffu); f[5] = bf2f(w.z >> 16); f[6] = bf2f(w.w & 0xffffu); f[7] = bf2f(w.w >> 16); }
__device__ __forceinline__ float wave_sum(float v) {
#pragma unroll
    for (int o = 1; o < 64; o <<= 1) v += __shfl_xor(v, o);
    return v;
}
__device__ __forceinline__ float sigmoidf_(float x) { return 1.0f / (1.0f + __expf(-x)); }
__device__ __forceinline__ float gelu_tanh(float x) { const float z = 0.7978845608028654f * (x + 0.044715f * x * x * x); return x / (1.0f + __expf(-2.0f * z)); }

__device__ __forceinline__ int rope_phys(int d) { return d < 32 ? 8 * (d >> 2) + (d & 3) : 8 * ((d - 32) >> 2) + 4 + (d & 3); }

__device__ const double INV_FREQ[32] = {1.0, 0.7498942093324559, 0.5623413251903491, 0.4216965034285822, 0.31622776601683794, 0.23713737056616552, 0.1778279410038923, 0.1333521432163324, 0.1,
    0.07498942093324558, 0.05623413251903491, 0.042169650342858224, 0.03162277660168379, 0.023713737056616554, 0.01778279410038923, 0.01333521432163324, 0.01, 0.007498942093324558,
    0.005623413251903491, 0.004216965034285823, 0.0031622776601683794, 0.0023713737056616554, 0.0017782794100389228, 0.001333521432163324, 0.001, 0.0007498942093324559,
    0.0005623413251903491, 0.00042169650342858224, 0.00031622776601683794, 0.00023713737056616554, 0.00017782794100389227, 0.0001333521432163324};

__device__ __forceinline__ void sincos_d(double ang, float& s, float& c) {
    const double k = __builtin_rint(ang * 0.6366197723675814);
    const double r = ang - k * 1.5707963267948966;
    const double r2 = r * r;
    double sp = -1.0 / 1307674368000.0; sp = sp * r2 + 1.0 / 6227020800.0; sp = sp * r2 - 1.0 / 39916800.0; sp = sp * r2 + 1.0 / 362880.0; sp = sp * r2 - 1.0 / 5040.0; sp = sp * r2 + 1.0 / 120.0; sp = sp * r2 - 1.0 / 6.0; sp = sp * r2 + 1.0;
    const double sn = sp * r;
    double cp = 1.0 / 87178291200.0; cp = cp * r2 - 1.0 / 479001600.0; cp = cp * r2 + 1.0 / 3628800.0; cp = cp * r2 - 1.0 / 40320.0; cp = cp * r2 + 1.0 / 720.0; cp = cp * r2 - 1.0 / 24.0; cp = cp * r2 + 0.5; const double cs = 1.0 - cp * r2;
    const int q = ((int)k) & 3;
    const double ss = (q == 0) ? sn : (q == 1) ? cs : (q == 2) ? -sn : -cs;
    const double cc = (q == 0) ? cs : (q == 1) ? -sn : (q == 2) ? -cs : sn;
    s = (float)ss; c = (float)cc;
}

template <class RowMap>
__device__ __forceinline__ void tr_item(const float* W, int N, int K, bf16_t* WT, const float* g, int item, int lane, RowMap rm) {
    const int nkb = K / 32, kb = item % nkb, nb = item / nkb, k0 = 32 * kb, n = 64 * nb + lane;
    const float* src = W + (size_t)k0 * N + n;
    float v[32];
#pragma unroll
    for (int i = 0; i < 32; ++i) v[i] = src[(size_t)i * N];
    if (g) {
#pragma unroll
        for (int i = 0; i < 32; ++i) v[i] *= g[k0 + i]; }
    bf16_t* dst = WT + (size_t)rm(n) * K + k0;
#pragma unroll
    for (int j = 0; j < 4; ++j) *(u32x4*)(dst + 8 * j) = pk8((f32x4){v[8 * j], v[8 * j + 1], v[8 * j + 2], v[8 * j + 3]}, (f32x4){v[8 * j + 4], v[8 * j + 5], v[8 * j + 6], v[8 * j + 7]});
}
struct MapId { int base; __device__ __forceinline__ int operator()(int n) const { return base + n; } };
struct MapQKV { __device__ __forceinline__ int operator()(int n) const { return n < 2048 ? (n & ~63) + rope_phys(n & 63) : n; } };
struct MapGate { int base; __device__ __forceinline__ int operator()(int d) const { return base + 8 * (d >> 2) + (d & 3); } };

__device__ __forceinline__ void prologue_work(const Params& p, int gw, int nw, int lane) {
    unsigned char* ws = p.ws;
    constexpr int IT_QKV = 32 * 48, IT_SQ = 32 * 16, IT_W1 = 32 * 64, IT_W2 = 128 * 16, IT_G = 8 * 4;
    constexpr int NIT = IT_QKV + IT_SQ + 2 * IT_W1 + 2 * IT_W2 + 2 * IT_SQ + 8 * IT_G + IT_SQ;
    for (int it = gw; it < NIT; it += nw) {
        int r = it;
        if (r < IT_QKV) { tr_item(p.in[I_WQKV], 3072, 1024, (bf16_t*)(ws + WS_WQKV), p.in[I_MIXG], r, lane, MapQKV{}); continue; } r -= IT_QKV;
        if (r < IT_SQ) { tr_item(p.in[I_WO], 1024, 1024, (bf16_t*)(ws + WS_WO), nullptr, r, lane, MapId{0}); continue; } r -= IT_SQ;
        if (r < 2 * IT_W1) { const int l = r / IT_W1; tr_item(p.in[I_W1] + (size_t)l * 1024 * 4096, 4096, 1024, (bf16_t*)(ws + WS_W1 + l * 8 * MiB), p.in[I_MLPG] + l * 1024, r % IT_W1, lane, MapId{0}); continue; } r -= 2 * IT_W1;
        if (r < 2 * IT_W2) { const int l = r / IT_W2; tr_item(p.in[I_W2] + (size_t)l * 1024 * 4096, 1024, 4096, (bf16_t*)(ws + WS_W2 + l * 8 * MiB), nullptr, r % IT_W2, lane, MapId{0}); continue; } r -= 2 * IT_W2;
        if (r < IT_SQ) { tr_item(p.in[I_RWY], 1024, 1024, (bf16_t*)(ws + WS_WYX), p.in[I_MIXG] + 1024, r, lane, MapId{0}); continue; } r -= IT_SQ;
        if (r < IT_SQ) { tr_item(p.in[I_RWX], 1024, 1024, (bf16_t*)(ws + WS_WYX), p.in[I_MIXG] + 1024, r, lane, MapId{1024}); continue; } r -= IT_SQ;
        if (r < 8 * IT_G) { const int w = r / IT_G, grp = w & 3, isi = w >> 2;
            tr_item(p.in[isi ? I_RWI : I_RWA] + (size_t)grp * 65536, 256, 256, (bf16_t*)(ws + WS_WG), nullptr, r % IT_G, lane, MapGate{grp * 512 + isi * 4}); continue; } r -= 8 * IT_G;
        tr_item(p.in[I_RWO], 1024, 1024, (bf16_t*)(ws + WS_WRO), nullptr, r, lane, MapId{0});
    }
    float* par = (float*)(ws + WS_PAR);
    float* cosT = (float*)(ws + WS_ROPE); float* sinT = cosT + 4096 * 32;
    for (int e = gw * 64 + lane; e < 4096 * 32; e += nw * 64) { const int pos = e >> 5, i = e & 31; float s, c; sincos_d((double)pos * INV_FREQ[i], s, c); cosT[e] = c; sinT[e] = s; }
    for (int c = gw * 64 + lane; c < 1024; c += nw * 64) {
        const float x = -p.in[I_RLAM][c]; const float z = __expf(-fabsf(x));
        const float l1p = (z < 0.02f) ? z * (1.0f + z * (-0.5f + z * (0.33333333f + z * (-0.25f + z * 0.2f)))) : __logf(1.0f + z);
        par[256 + c] = 8.0f * (fmaxf(x, 0.f) + l1p);
    }
    if (gw == 0) { float a = p.in[I_LQ1][lane] * p.in[I_LK1][lane], b = p.in[I_LQ2][lane] * p.in[I_LK2][lane]; a = wave_sum(a); b = wave_sum(b);
        if (lane == 0) par[0] = expf(a) - expf(b) + LAMBDA_INIT; }
    bf16_t* XB = (bf16_t*)(ws + WS_XB); float* ssq0 = (float*)(ws + WS_SSQ);
    for (int m = gw; m < M; m += nw) {
        const f32x4* xr = (const f32x4*)(p.in[I_X] + (size_t)m * DM) + lane; float s = 0.f;
        u32x2* o8 = (u32x2*)(XB + (size_t)m * DM) + lane;
#pragma unroll
        for (int j = 0; j < 4; ++j) { const f32x4 v = xr[64 * j]; s += (v.x * v.x + v.y * v.y) + (v.z * v.z + v.w * v.w); u32x2 w; w.x = pk2(v.x, v.y); w.y = pk2(v.z, v.w); o8[64 * j] = w; }
        s = wave_sum(s); if (lane == 0) ssq0[m] = s;
    }
}

struct EpiQKV {
    const float* ssq; const float* cosT; const float* sinT; bf16_t* Q;
    struct Ctx { float rs; int pos; };
    __device__ __forceinline__ Ctx row(int r) const { Ctx c; c.rs = rsqrtf(ssq[r] * (1.0f / DM) + NORM_EPS); c.pos = r & (SEQ - 1); return c; }
    __device__ __forceinline__ float apply(const Ctx& c, int r, int c0, f32x4 lo, f32x4 hi) const {
        lo = lo * c.rs; hi = hi * c.rs;
        const int sec = c0 >> 10, cc = c0 & 1023;
        if (sec < 2) { const int g = (c0 & 63) >> 3; const f32x4 cs = *(const f32x4*)(cosT + c.pos * 32 + 4 * g), sn = *(const f32x4*)(sinT + c.pos * 32 + 4 * g);
            f32x4 nlo = lo * cs - hi * sn, nhi = hi * cs + lo * sn; if (sec == 0) { nlo = nlo * C2; nhi = nhi * C2; } lo = nlo; hi = nhi; }
        *(u32x4*)(Q + (size_t)sec * ((size_t)M * DM) + (size_t)r * DM + cc) = pk8(lo, hi);
        return 0.f;
    }
    __device__ __forceinline__ void row_end(int, float) const {}
    static constexpr bool HAS_ROW_END = false;
};
struct EpiRes {
    const float* xin; float* xout; bf16_t* XB; float* ssq;
    struct Ctx { int dummy; };
    __device__ __forceinline__ Ctx row(int) const { return Ctx{0}; }
    __device__ __forceinline__ float apply(const Ctx&, int r, int c0, f32x4 lo, f32x4 hi) const {
        const size_t off = (size_t)r * DM + c0;
        const f32x4 a = *(const f32x4*)(xin + off) + lo, b = *(const f32x4*)(xin + off + 4) + hi;
        *(f32x4*)(xout + off) = a; *(f32x4*)(xout + off + 4) = b;
        if (XB) *(u32x4*)(XB + off) = pk8(a, b);
        return (a[0] * a[0] + a[1] * a[1]) + (a[2] * a[2] + a[3] * a[3]) + (b[0] * b[0] + b[1] * b[1]) + (b[2] * b[2] + b[3] * b[3]);
    }
    __device__ __forceinline__ void row_end(int r, float s) const { if (ssq) atomicAdd(ssq + r, s); }
    static constexpr bool HAS_ROW_END = true;
};
struct EpiUp {
    const float* ssq; bf16_t* H;
    struct Ctx { float rs; };
    __device__ __forceinline__ Ctx row(int r) const { return Ctx{rsqrtf(ssq[r] * (1.0f / DM) + NORM_EPS)}; }
    __device__ __forceinline__ float apply(const Ctx& c, int r, int c0, f32x4 lo, f32x4 hi) const {
        lo = lo * c.rs; hi = hi * c.rs;
#pragma unroll
        for (int j = 0; j < 4; ++j) { const float a = fmaxf(lo[j], 0.f), b = fmaxf(hi[j], 0.f); lo[j] = a * a; hi[j] = b * b; }
        *(u32x4*)(H + (size_t)r * FF + c0) = pk8(lo, hi); return 0.f;
    }
    __device__ __forceinline__ void row_end(int, float) const {}
    static constexpr bool HAS_ROW_END = false;
};
struct EpiRecIn {
    const float* ssq; bf16_t* Y; bf16_t* XP;
    struct Ctx { float rs; };
    __device__ __forceinline__ Ctx row(int r) const { return Ctx{rsqrtf(ssq[r] * (1.0f / DM) + NORM_EPS)}; }
    __device__ __forceinline__ float apply(const Ctx& c, int r, int c0, f32x4 lo, f32x4 hi) const {
        lo = lo * c.rs; hi = hi * c.rs;
        if (c0 < 1024) {
#pragma unroll
            for (int j = 0; j < 4; ++j) { lo[j] = gelu_tanh(lo[j]); hi[j] = gelu_tanh(hi[j]); }
            *(u32x4*)(Y + (size_t)r * DM + c0) = pk8(lo, hi);
        } else *(u32x4*)(XP + (size_t)r * DM + (c0 - 1024)) = pk8(lo, hi);
        return 0.f;
    }
    __device__ __forceinline__ void row_end(int, float) const {}
    static constexpr bool HAS_ROW_END = false;
};
struct EpiGates {
    const float* ba; const float* bi; const float* sp8; const bf16_t* XC; bf16_t* LAU;
    struct Ctx { int dummy; };
    __device__ __forceinline__ Ctx row(int) const { return Ctx{0}; }
    __device__ __forceinline__ float apply(const Ctx&, int r, int c0, f32x4 lo, f32x4 hi) const {
        const int grp = c0 >> 9, q = (c0 & 511) >> 3, ch = grp * 256 + 4 * q;
        const f32x4 b_a = *(const f32x4*)(ba + ch), b_i = *(const f32x4*)(bi + ch), sp = *(const f32x4*)(sp8 + ch);
        const u32x2 xw = *(const u32x2*)(XC + (size_t)r * DM + ch);
        const float xc[4] = {bf2f(xw.x & 0xffffu), bf2f(xw.x >> 16), bf2f(xw.y & 0xffffu), bf2f(xw.y >> 16)};
        unsigned w[4];
#pragma unroll
        for (int j = 0; j < 4; ++j) {
            const float rg = sigmoidf_(lo[j] + b_a[j]), ig = sigmoidf_(hi[j] + b_i[j]);
            const float la = -rg * sp[j];
            const float t = 2.0f * la;
            const float om = (t > -0.05f) ? -t * (1.0f + t * (0.5f + t * (0.16666667f + t * 0.041666668f))) : 1.0f - __expf(t);
            const float u = sqrtf(fmaxf(om, 0.f)) * ig * xc[j];
            w[j] = pk2(la, u);
        }
        u32x4 o; o.x = w[0]; o.y = w[1]; o.z = w[2]; o.w = w[3];
        *(u32x4*)(LAU + ((size_t)r * DM + ch) * 2) = o; return 0.f;
    }
    __device__ __forceinline__ void row_end(int, float) const {}
    static constexpr bool HAS_ROW_END = false;
};

constexpr int ATN_LDS = (64 * 129 * 2 + 64 * 128 + 2 * 64 * 65 + 256) * 4;

namespace pg8 {
#define PG8_LAS __attribute__((address_space(3)))
typedef short bf16x8 __attribute__((ext_vector_type(8)));
constexpr int BM = 256, BK = 64, HALF = 128, HTB = HALF * BK * 2  , STAGE_BYTES = 8 * HTB, NXCD = 8, WGM = 8;
__host__ __device__ __forceinline__ int lds_byte(int r, int c) { const int st = (r >> 4) * 2 + (c >> 5), rr = r & 15, cc = c & 31, ob = rr * 64 + cc * 2; return st * 1024 + (ob ^ (((ob >> 9) & 1) << 5)); }
__host__ __device__ __forceinline__ void stage_rc(int b, int& R, int& C) { const int st = b / 1024, sb = b % 1024, swz = sb ^ (((sb >> 9) & 1) << 5); R = (st >> 1) * 16 + swz / 64; C = (st & 1) * 32 + (swz % 64) / 2; }
__host__ __device__ __forceinline__ int perm32(int rho) { const int n = rho >> 4, i = rho & 15; return 8 * (i >> 2) + 4 * n + (i & 3); }
struct Unit { int pm, pn; };
struct Gemm { const bf16_t* A; const bf16_t* Bt; int M, N, K, lda, ldb, agrp; };
struct StaticOrder {
    int nM, nN, nwg, G, c;
    __host__ __device__ void init(int M, int N, int G_, int c_) { nM = M / BM; nN = N / BM; nwg = nM * nN; G = G_; c = c_; }
    __host__ __device__ bool next(int i, Unit& u) const {
        const long L = (long)i * G + c; if (L >= nwg) return false;
        int wgid = (int)L; { const int q = nwg / NXCD, r = nwg % NXCD, xcd = wgid % NXCD, off = wgid / NXCD; wgid = (xcd < r ? xcd * (q + 1) : r * (q + 1) + (xcd - r) * q) + off; }
        const int nig = WGM * nN, gid = wgid / nig, fm = gid * WGM, gsz = (nM - fm) < WGM ? (nM - fm) : WGM;
        u.pm = fm + ((wgid % nig) % gsz); u.pn = (wgid % nig) / gsz; return true;
    }
    __device__ __forceinline__ void a_ready(const Unit&) const {}
    __device__ __forceinline__ void done(const Unit&) const {}
};
template <class E8> struct EpiAdapt {
    static constexpr bool PERM = true, AFTER_DRAIN = false; E8 e;
    __device__ __forceinline__ void operator()(const f32x4 (&acc)[2][2][4][2], const Unit& u, int wr, int wc, int fr, int fq) const {
#pragma unroll
        for (int ai = 0; ai < 2; ++ai)
#pragma unroll
            for (int m = 0; m < 4; ++m) { const int row = u.pm * BM + ai * HALF + wr * 64 + m * 16 + fr; const typename E8::Ctx cx = e.row(row); float s = 0.f;
#pragma unroll
                for (int bj = 0; bj < 2; ++bj) s += e.apply(cx, row, u.pn * BM + bj * HALF + wc * 32 + 8 * fq, acc[ai][bj][m][0], acc[ai][bj][m][1]);
                if (E8::HAS_ROW_END) { s += __shfl_xor(s, 16); s += __shfl_xor(s, 32); if (fq == 0) e.row_end(row, s); } }
    }
};
template <class Epi, class Sched, bool ALIGN_EPI = false, bool SP2 = false>
__device__ __forceinline__ void gemm_phase(PG8_LAS unsigned char* lds, const Gemm g, const Sched& S, const Epi& E) {
    const int tid = threadIdx.x, wid = __builtin_amdgcn_readfirstlane(tid >> 6), lane = tid & 63, wr = wid >> 2, wc = wid & 3, fr = lane & 15, fq = lane >> 4;
    const int K = g.K, nt = K / BK;
    unsigned voffA[2], voffB[2];
#pragma unroll
    for (int i = 0; i < 2; ++i) { int R, C; stage_rc(tid * 16 + i * 8192, R, C); const int Rb = Epi::PERM ? ((R & ~31) + perm32(R & 31)) : R;
        voffA[i] = (unsigned)(R * g.lda + C) * 2u; voffB[i] = (unsigned)(Rb * g.ldb + C) * 2u; }
    const size_t kstep = (size_t)(BK * 2);
    const size_t hstepA = (size_t)HALF * g.lda * 2, hstepB = (size_t)HALF * g.ldb * 2;
    const size_t tstepA = 2 * hstepA, tstepB = 2 * hstepB;
#define PG8_ABASE(un) ((const char*)g.A + (size_t)(un).pm * tstepA + (g.agrp ? (size_t)((un).pn >> 1) * 512 : (size_t)0))
    const unsigned ldsw = (unsigned)wid * 1024u;
    const int aoff = lds_byte(wr * 64 + fr, fq * 8), boff = lds_byte(wc * 32 + fr, fq * 8);
#define PG8_SA(b, h) (((b) * 2 + (h)) * HTB)
#define PG8_SB(b, h) ((4 + (b) * 2 + (h)) * HTB)
#define PG8_STAGE(bufoff, gbase, voff) do { _Pragma("unroll") for (int _i = 0; _i < 2; ++_i) \
        __builtin_amdgcn_global_load_lds((const unsigned*)((const char*)(gbase) + (voff)[_i]), (PG8_LAS unsigned*)(lds + (bufoff) + ldsw + _i * 8192), 16, 0, 0); } while (0)
#define PG8_LDA(dst, b, h) do { _Pragma("unroll") for (int m = 0; m < 4; ++m) _Pragma("unroll") for (int k = 0; k < 2; ++k) dst[m][k] = *(const PG8_LAS bf16x8*)(lds + PG8_SA(b, h) + aoff + m * 2048 + k * 1024); } while (0)
#define PG8_LDB(dst, b, h) do { _Pragma("unroll") for (int n = 0; n < 2; ++n) _Pragma("unroll") for (int k = 0; k < 2; ++k) dst[n][k] = *(const PG8_LAS bf16x8*)(lds + PG8_SB(b, h) + boff + n * 2048 + k * 1024); } while (0)
#define PG8_MMA(ai, bj, At, Bt) do { __builtin_amdgcn_s_setprio(1); _Pragma("unroll") for (int m = 0; m < 4; ++m) _Pragma("unroll") for (int n = 0; n < 2; ++n) _Pragma("unroll") for (int k = 0; k < 2; ++k) \
        acc[ai][bj][m][n] = __builtin_amdgcn_mfma_f32_16x16x32_bf16(Bt[n][k], At[m][k], acc[ai][bj][m][n], 0, 0, 0); __builtin_amdgcn_s_setprio(0); } while (0)
#define PG8_WAIT_V(n) asm volatile("s_waitcnt vmcnt(" #n ")" ::: "memory")
#define PG8_WAIT_L(n) asm volatile("s_waitcnt lgkmcnt(" #n ")" ::: "memory")
#define PG8_BAR __builtin_amdgcn_s_barrier()
#define PG8_SCHED __builtin_amdgcn_sched_barrier(0)
    Unit cur, nxt; int ui = 0;
    if (!S.next(0, cur)) return;
    f32x4 acc[2][2][4][2];
#pragma unroll
    for (int a = 0; a < 2; ++a)
#pragma unroll
        for (int b = 0; b < 2; ++b)
#pragma unroll
            for (int m = 0; m < 4; ++m)
#pragma unroll
                for (int n = 0; n < 2; ++n) acc[a][b][m][n] = (f32x4){0.f, 0.f, 0.f, 0.f};
    bf16x8 At[4][2], B0[2][2], B1[2][2];
    const char* cA = PG8_ABASE(cur); const char* cB = (const char*)g.Bt + (size_t)cur.pn * tstepB;
    S.a_ready(cur);
    if constexpr (SP2) {
        PG8_STAGE(PG8_SB(0, 0), cB, voffB); PG8_STAGE(PG8_SB(0, 1), cB + hstepB, voffB); PG8_STAGE(PG8_SA(0, 0), cA, voffA); PG8_STAGE(PG8_SA(0, 1), cA + hstepA, voffA);
        if (wr == 1) PG8_BAR;
        PG8_WAIT_V(2); PG8_BAR;
        PG8_STAGE(PG8_SB(1, 0), cB + kstep, voffB); PG8_STAGE(PG8_SA(1, 0), cA + kstep, voffA); PG8_STAGE(PG8_SB(1, 1), cB + hstepB + kstep, voffB);
        PG8_WAIT_V(6); PG8_BAR;
    } else {
        PG8_STAGE(PG8_SB(0, 0), cB, voffB); PG8_STAGE(PG8_SA(0, 0), cA, voffA); PG8_STAGE(PG8_SB(0, 1), cB + hstepB, voffB); PG8_STAGE(PG8_SA(0, 1), cA + hstepA, voffA);
        if (wr == 1) PG8_BAR;
        PG8_WAIT_V(4); PG8_BAR;
        PG8_STAGE(PG8_SB(1, 0), cB + kstep, voffB); PG8_STAGE(PG8_SA(1, 0), cA + kstep, voffA); PG8_STAGE(PG8_SB(1, 1), cB + hstepB + kstep, voffB);
        PG8_WAIT_V(6); PG8_BAR;
    }
    for (;;) {
        const bool has_next = S.next(ui + 1, nxt);
        const char* nA = has_next ? PG8_ABASE(nxt) : cA; const char* nB = has_next ? (const char*)g.Bt + (size_t)nxt.pn * tstepB : cB;
        for (int t = 0; t < nt; t += 2) {
            const bool last = (t == nt - 2);
            const char* a1 = cA + (size_t)(t + 1) * kstep;
            const char* a2 = last ? nA : cA + (size_t)(t + 2) * kstep; const char* b2 = last ? nB : cB + (size_t)(t + 2) * kstep;
            const char* a3 = a2 + kstep; const char* b3 = b2 + kstep;
            if (last && has_next) S.a_ready(nxt);
            if constexpr (SP2) {
            PG8_LDB(B0, 0, 0); PG8_LDB(B1, 0, 1); PG8_SCHED; PG8_LDA(At, 0, 0); PG8_STAGE(PG8_SA(1, 1), a1 + hstepA, voffA);
            PG8_WAIT_V(8); PG8_WAIT_L(0); PG8_BAR; PG8_MMA(0, 0, At, B0); PG8_MMA(0, 1, At, B1); PG8_BAR; PG8_SCHED;
            PG8_LDA(At, 0, 1); PG8_STAGE(PG8_SB(0, 0), b2, voffB); PG8_STAGE(PG8_SB(0, 1), b2 + hstepB, voffB); PG8_STAGE(PG8_SA(0, 0), a2, voffA);
            PG8_WAIT_V(8); PG8_WAIT_L(0); PG8_BAR; PG8_MMA(1, 0, At, B0); PG8_MMA(1, 1, At, B1); PG8_BAR; PG8_SCHED;
            PG8_LDB(B0, 1, 0); PG8_LDB(B1, 1, 1); PG8_SCHED; PG8_LDA(At, 1, 0); PG8_STAGE(PG8_SA(0, 1), a2 + hstepA, voffA);
            PG8_WAIT_V(8); PG8_WAIT_L(0); PG8_BAR; PG8_MMA(0, 0, At, B0); PG8_MMA(0, 1, At, B1); PG8_BAR; PG8_SCHED;
            PG8_LDA(At, 1, 1); PG8_STAGE(PG8_SB(1, 0), b3, voffB); PG8_STAGE(PG8_SB(1, 1), b3 + hstepB, voffB); PG8_STAGE(PG8_SA(1, 0), a3, voffA);
            PG8_WAIT_V(8); PG8_WAIT_L(0); PG8_BAR; PG8_MMA(1, 0, At, B0); PG8_MMA(1, 1, At, B1); PG8_BAR; PG8_SCHED;
            } else {
            PG8_LDB(B0, 0, 0); PG8_SCHED; PG8_LDA(At, 0, 0); PG8_STAGE(PG8_SA(1, 1), a1 + hstepA, voffA);
            PG8_WAIT_L(8); PG8_BAR; PG8_WAIT_L(0); PG8_MMA(0, 0, At, B0); PG8_BAR; PG8_SCHED;
            PG8_LDB(B1, 0, 1); PG8_STAGE(PG8_SB(0, 0), b2, voffB);
            PG8_BAR; PG8_WAIT_L(0); PG8_MMA(0, 1, At, B1); PG8_BAR;
            PG8_LDA(At, 0, 1); PG8_STAGE(PG8_SA(0, 0), a2, voffA);
            PG8_BAR; PG8_WAIT_L(0); PG8_MMA(1, 0, At, B0); PG8_BAR; PG8_SCHED;
            PG8_STAGE(PG8_SB(0, 1), b2 + hstepB, voffB);
            PG8_WAIT_V(6); PG8_BAR; PG8_MMA(1, 1, At, B1); PG8_BAR;
            PG8_LDB(B0, 1, 0); PG8_SCHED; PG8_LDA(At, 1, 0); PG8_STAGE(PG8_SA(0, 1), a2 + hstepA, voffA);
            PG8_WAIT_L(8); PG8_BAR; PG8_WAIT_L(0); PG8_MMA(0, 0, At, B0); PG8_BAR; PG8_SCHED;
            PG8_LDB(B1, 1, 1); PG8_STAGE(PG8_SB(1, 0), b3, voffB);
            PG8_BAR; PG8_WAIT_L(0); PG8_MMA(0, 1, At, B1); PG8_BAR;
            PG8_LDA(At, 1, 1); PG8_STAGE(PG8_SA(1, 0), a3, voffA);
            PG8_BAR; PG8_WAIT_L(0); PG8_MMA(1, 0, At, B0); PG8_BAR; PG8_SCHED;
            PG8_STAGE(PG8_SB(1, 1), b3 + hstepB, voffB);
            PG8_WAIT_V(6); PG8_BAR; PG8_MMA(1, 1, At, B1); PG8_BAR;
            }
        }
        if constexpr (ALIGN_EPI) { if (wr == 0) PG8_BAR; }
        if constexpr (!Epi::AFTER_DRAIN) { E(acc, cur, wr, wc, fr, fq); S.done(cur); }
        if (!has_next) break;
#pragma unroll
        for (int a = 0; a < 2; ++a)
#pragma unroll
            for (int b = 0; b < 2; ++b)
#pragma unroll
                for (int m = 0; m < 4; ++m)
#pragma unroll
                    for (int n = 0; n < 2; ++n) acc[a][b][m][n] = (f32x4){0.f, 0.f, 0.f, 0.f};
        cur = nxt; cA = nA; cB = nB; ++ui;
        if constexpr (ALIGN_EPI) { if (wr == 1) PG8_BAR; }
    }
    PG8_WAIT_V(0);
    if constexpr (!ALIGN_EPI) { if (wr == 0) PG8_BAR; }
    PG8_BAR;
    if constexpr (Epi::AFTER_DRAIN) { E.fused(acc, cur, wr, wc, fr, fq, lds, wid, lane); S.done(cur); }
#undef PG8_SA
#undef PG8_SB
#undef PG8_STAGE
#undef PG8_LDA
#undef PG8_LDB
#undef PG8_MMA
#undef PG8_WAIT_V
#undef PG8_WAIT_L
#undef PG8_BAR
#undef PG8_SCHED
#undef PG8_ABASE
}
}

constexpr int NWAVES = 8;
constexpr int RING_BYTES = 131072, LDSCTL_OFF = 135168, MISC_OFF = LDSCTL_OFF + 320, LDS_BYTES = 147456;
constexpr int CW_BAR = 4096;
constexpr int NPH = 14;
#define GAS __attribute__((address_space(1)))
typedef GAS unsigned gu32;
#define RLX_AGENT __ATOMIC_RELAXED, __HIP_MEMORY_SCOPE_AGENT
#define XB_TMO      128
#define XB_XCNT(j)  (256  + 64 * (j))
#define XB_XSUB(j)  (1280 + 64 * (j))
#define XB_XGEN(j)  (2304 + 64 * (j))
#define XB_TOP      3328
#define XB_TOPGEN   3392
#define XCD_BAR_WORDS 3456
#define XB_SPIN_CAP (1u << 18)

__device__ __forceinline__ unsigned xb_ld(unsigned* p)              { return __hip_atomic_load(p, __ATOMIC_RELAXED, __HIP_MEMORY_SCOPE_AGENT); }
__device__ __forceinline__ unsigned xb_add(unsigned* p, unsigned v) { return __hip_atomic_fetch_add(p, v, __ATOMIC_RELAXED, __HIP_MEMORY_SCOPE_AGENT); }
__device__ __forceinline__ unsigned xb_xcc_id() { return (unsigned)__builtin_amdgcn_s_getreg((3 << 11) | 20) & 0xFu; }
#define XB_SPIN(cond, bar) do { unsigned _sp = 0; while (cond) { __builtin_amdgcn_s_sleep(1); \
    if ((++_sp & 255u) == 0u) { if (xb_ld(&(bar)[XB_TMO])) break; if (_sp > XB_SPIN_CAP) { atomicAdd(&(bar)[XB_TMO], 1u); break; } } } } while (0)

struct XcdBarrier {
    unsigned* bar; unsigned x;
    volatile LAS unsigned* st;
};

__device__ __forceinline__ XcdBarrier xcd_barrier_post(unsigned* bar, volatile LAS unsigned* st) {
    XcdBarrier b; b.bar = bar; b.x = xb_xcc_id(); b.st = st;
    if (threadIdx.x == 0) (void)xb_add(&bar[XB_XCNT(b.x)], 1u);
    return b;
}
__device__ __forceinline__ void xcd_barrier_complete(unsigned* bar, unsigned x, unsigned& nloc, unsigned& nx) {
    const unsigned G = gridDim.x * gridDim.y * gridDim.z;
    unsigned sum, cnt, mine, sp = 0u;
    for (;;) {
        sum = 0u; cnt = 0u; mine = 0u;
#pragma unroll
        for (unsigned j = 0; j < 16; ++j) { const unsigned c = xb_ld(&bar[XB_XCNT(j)]); sum += c; cnt += (c > 0u) ? 1u : 0u; mine = (j == x) ? c : mine; }
        if (sum == G) break;
        __builtin_amdgcn_s_sleep(1);
        if ((++sp & 255u) == 0u) { if (xb_ld(&bar[XB_TMO])) break; if (sp > XB_SPIN_CAP) { atomicAdd(&bar[XB_TMO], 1u); break; } }
    }
    nloc = mine > 0u ? mine : 1u; nx = cnt > 0u ? cnt : 1u;
}

__device__ __forceinline__ void xcd_barrier(const XcdBarrier& b) {
    asm volatile("s_waitcnt vmcnt(0)" ::: "memory");
    __syncthreads();
    if (threadIdx.x == 0) {
        unsigned* bar = b.bar;
        __builtin_amdgcn_s_waitcnt(0);
        unsigned nloc = b.st[0], nx = b.st[1];
        if (nloc == 0u) { xcd_barrier_complete(bar, b.x, nloc, nx); b.st[0] = nloc; b.st[1] = nx; }
        const unsigned old = xb_add(&bar[XB_XSUB(b.x)], 1u);
        const unsigned gen = old / nloc;
        if (old + 1u == (gen + 1u) * nloc) {
            __builtin_amdgcn_fence(__ATOMIC_RELEASE, "agent");
            asm volatile("s_waitcnt vmcnt(0)" ::: "memory");
            const unsigned og = xb_add(&bar[XB_TOP], 1u);
            const unsigned tg = og / nx;
            if (og + 1u == (tg + 1u) * nx) xb_add(&bar[XB_TOPGEN], 1u);
            else XB_SPIN(xb_ld(&bar[XB_TOPGEN]) == tg, bar);
            __builtin_amdgcn_fence(__ATOMIC_ACQUIRE, "agent");
            xb_add(&bar[XB_XGEN(b.x)], 1u);
            asm volatile("s_waitcnt vmcnt(0)" ::: "memory");
        } else {
            XB_SPIN(xb_ld(&bar[XB_XGEN(b.x)]) == gen, bar);
            __builtin_amdgcn_fence(__ATOMIC_ACQUIRE, "agent");
            asm volatile("s_waitcnt vmcnt(0)" ::: "memory");
        }
    }
    __syncthreads();
}


namespace attn {
using bf16x8 = __attribute__((ext_vector_type(8))) short;
using s16x4 = __attribute__((ext_vector_type(4))) short;
using f32x16 = __attribute__((ext_vector_type(16))) float;
typedef short v4i16_t __attribute__((ext_vector_type(4)));
typedef __attribute__((address_space(3))) const char* lds_cptr;
constexpr int SLOTB = 16384, NSLOT = 3;
constexpr int LDS_K = 0, LDS_V = NSLOT * SLOTB, LDS_WS = 2 * NSLOT * SLOTB, LDS_END = LDS_WS + 8 * 256;
constexpr int STG_ROW = 132;
#ifndef ATTN_THR
#define ATTN_THR 8
#endif
__device__ __forceinline__ int crow(int r, int hi) { return (r & 3) + 8 * (r >> 2) + 4 * hi; }
#define SBAR() __builtin_amdgcn_sched_barrier(0)
#define WAIT_BAR(N) asm volatile("s_waitcnt vmcnt(" #N ") lgkmcnt(0)\n\ts_barrier" ::: "memory")
__device__ __forceinline__ void glds16(const void* gsrc, unsigned lds_dst) { unsigned keep;
    asm volatile("s_mov_b32 %0, m0\n\ts_mov_b32 m0, %2\n\ts_nop 0\n\tglobal_load_lds_dwordx4 %1, off\n\ts_mov_b32 m0, %0" : "=&s"(keep) : "v"(gsrc), "s"(lds_dst) : "memory"); }
typedef float f32x2_t __attribute__((ext_vector_type(2))); typedef __bf16 bf16x2_t __attribute__((ext_vector_type(2)));
__device__ __forceinline__ unsigned cvtpk(float lo, float hi) { f32x2_t v = {lo, hi}; bf16x2_t b = __builtin_convertvector(v, bf16x2_t); return __builtin_bit_cast(unsigned, b); }
__device__ __forceinline__ s16x4 vtr(lds_cptr p) { return __builtin_bit_cast(s16x4, __builtin_amdgcn_ds_read_tr16_b64_v4i16((__attribute__((address_space(3))) v4i16_t*)p)); }
__device__ __forceinline__ bf16x8 ldk(lds_cptr p) { return *(const __attribute__((address_space(3))) bf16x8*)p; }
__device__ __forceinline__ float swapmax(float m) { auto rr = __builtin_amdgcn_permlane32_swap(__float_as_uint(m), __float_as_uint(m), false, false); return __builtin_fmaxf(__uint_as_float(rr[0]), __uint_as_float(rr[1])); }
__device__ __forceinline__ float swapsum(float m) { auto rr = __builtin_amdgcn_permlane32_swap(__float_as_uint(m), __float_as_uint(m), false, false); return __uint_as_float(rr[0]) + __uint_as_float(rr[1]); }

__device__ __forceinline__ void attn_unit(int b, int h, int j, const bf16_t* Q, const bf16_t* __restrict__ K, const bf16_t* __restrict__ V, bf16_t* O, const float* subg, float lam, LAS unsigned char* shm) {
    const int tid = threadIdx.x, lane = tid & 63, r32 = lane & 31, hi = lane >> 5; const int wid = __builtin_amdgcn_readfirstlane(tid >> 6);
    const int rg = wid >> 1, c = wid & 1;
    const size_t rowbase = (size_t)b * SEQ; const int q0 = j * 128;
    const int NT = 2 * j + 2;
    const int NTW = 2 * j + 1 + (rg >> 1);
    const bf16_t* Qw = Q + (rowbase + q0 + rg * 32) * DM + h * 128 + c * 64;
    const char* Kh = (const char*)(K + rowbase * DM + h * 128); const char* Vh = (const char*)(V + rowbase * DM + h * 128);
    const unsigned lds0 = (unsigned)(uintptr_t)shm;
    LAS float* wsf = (LAS float*)(shm + LDS_WS) + wid * 64;
    const char* ksrc[2]; const char* vsrc[2];
#pragma unroll
    for (int i = 0; i < 2; ++i) { const int p = 2 * wid + i, key = 4 * p + (lane >> 4), ch = (lane & 15) ^ (key & 15); ksrc[i] = Kh + (size_t)key * (DM * 2) + ch * 16;
        const int d0 = p >> 2, kg = p & 3, vkey = 16 * kg + (lane >> 2); vsrc[i] = Vh + (size_t)vkey * (DM * 2) + d0 * 64 + (lane & 3) * 16; }
    const unsigned kdst = lds0 + LDS_K + wid * 2048, vdst = lds0 + LDS_V + wid * 2048;
#define DMA_K(t, slot) do { glds16(ksrc[0] + (size_t)(t) * (64 * DM * 2), (unsigned)__builtin_amdgcn_readfirstlane(kdst + (slot))); glds16(ksrc[1] + (size_t)(t) * (64 * DM * 2), (unsigned)__builtin_amdgcn_readfirstlane(kdst + (slot) + 1024)); } while (0)
#define DMA_V(t, slot) do { glds16(vsrc[0] + (size_t)(t) * (64 * DM * 2), (unsigned)__builtin_amdgcn_readfirstlane(vdst + (slot))); glds16(vsrc[1] + (size_t)(t) * (64 * DM * 2), (unsigned)__builtin_amdgcn_readfirstlane(vdst + (slot) + 1024)); } while (0)
    const lds_cptr shm3 = (lds_cptr)shm;
    const int kch = ((8 * c + hi) ^ (r32 & 15)) * 16;
    const lds_cptr kp0 = shm3 + LDS_K + r32 * 256;
    const lds_cptr vp0 = shm3 + LDS_V + ((lane >> 4) & 1) * 32 + (lane & 3) * 8 + (4 * hi + ((lane & 15) >> 2)) * 64;
#define KFR(slot, kb, ks) ldk(kp0 + (slot) + (kb) * 8192 + (kch ^ ((ks) * 32)))
    DMA_K(0, 0); DMA_V(0, 0); DMA_K(1, SLOTB);
    bf16x8 qr[4];
#pragma unroll
    for (int ks = 0; ks < 4; ++ks) qr[ks] = *reinterpret_cast<const bf16x8*>(&Qw[(size_t)r32 * DM + ks * 16 + hi * 8]);
    if (2 < NT) DMA_K(2, 2 * SLOTB);
    float mhat = 0.f, l_reg = 0.f; f32x16 o[4];
#pragma unroll
    for (int d = 0; d < 4; ++d) o[d] = f32x16{};
    bool resc = false;
    f32x16 C0, C1;
    u32x4 pw0, pw1, pw2, pw3;
    bf16x8 kf[8];
    int sl_prev = 0, sl_cur = 0, sl_next = SLOTB;
#define ROT() do { sl_prev = sl_cur; sl_cur = sl_next; sl_next = (sl_next == (NSLOT - 1) * SLOTB) ? 0 : sl_next + SLOTB; } while (0)
#define RESC() do { if (resc) { asm volatile("s_waitcnt lgkmcnt(0)" ::: "memory"); \
        _Pragma("unroll") for (int d_ = 0; d_ < 4; ++d_) _Pragma("unroll") for (int r = 0; r < 16; ++r) o[d_][r] *= wsf[crow(r, hi)]; } } while (0)
#define PKW(P, B) cvtpk(P[B], P[B + 1])
#define PAF(k) __builtin_bit_cast(bf16x8, pw##k)
#define PIN(x) asm volatile("" : "+v"(x))
#define MX3(a, b, c) __builtin_fmaxf(__builtin_fmaxf((a), (b)), (c))
#define EX(v) __builtin_amdgcn_exp2f(v)
    WAIT_BAR(0);
    {
#pragma unroll
        for (int i = 0; i < 8; ++i) kf[i] = KFR(0, i >> 2, i & 3);
        C0 = f32x16{}; C1 = f32x16{};
#pragma unroll
        for (int ks = 0; ks < 4; ++ks) { C0 = __builtin_amdgcn_mfma_f32_32x32x16_bf16(kf[ks], qr[ks], C0, 0, 0, 0); C1 = __builtin_amdgcn_mfma_f32_32x32x16_bf16(kf[4 + ks], qr[ks], C1, 0, 0, 0); }
        float a = C0[0];
#pragma unroll
        for (int r = 1; r < 16; ++r) a = __builtin_fmaxf(a, C0[r]);
#pragma unroll
        for (int r = 0; r < 16; ++r) a = __builtin_fmaxf(a, C1[r]);
        const float rm = swapmax(a); mhat = rm; float sacc = 0.f;
#pragma unroll
        for (int r = 0; r < 16; ++r) { C0[r] = EX(C0[r] - rm); C1[r] = EX(C1[r] - rm); sacc += C0[r] + C1[r]; }
        l_reg = sacc;
        pw0 = (u32x4){PKW(C0, 0), PKW(C0, 2), PKW(C0, 4), PKW(C0, 6)}; pw1 = (u32x4){PKW(C0, 8), PKW(C0, 10), PKW(C0, 12), PKW(C0, 14)};
        pw2 = (u32x4){PKW(C1, 0), PKW(C1, 2), PKW(C1, 4), PKW(C1, 6)}; pw3 = (u32x4){PKW(C1, 8), PKW(C1, 10), PKW(C1, 12), PKW(C1, 14)};
    }
    WAIT_BAR(0);
    if (3 < NT) DMA_K(3, 0);
    DMA_V(1, SLOTB);
    ROT();
#pragma unroll
    for (int i = 0; i < 8; ++i) kf[i] = KFR(sl_cur, i >> 2, i & 3);
    WAIT_BAR(4);
    s16x4 vlo[8], vhi[8];
#define VFR(i) (bf16x8){vlo[i][0], vlo[i][1], vlo[i][2], vlo[i][3], vhi[i][0], vhi[i][1], vhi[i][2], vhi[i][3]}
#define VRD(i, d0) do { vlo[i] = vtr(vp_ + ((d0) * 4096 + ((i) & 3) * 1024)); vhi[i] = vtr(vp_ + ((d0) * 4096 + ((i) & 3) * 1024 + 512)); } while (0)
#define GAPA(MF, i, d0) do { VRD(i, d0); SBAR(); MF; SBAR(); } while (0)
#define GAPB(MF, X, B, PWN, W) do { MF; X[B] = EX(X[B]); X[B + 1] = EX(X[B + 1]); sacc += X[B]; sacc += X[B + 1]; PWN[W] = PKW(X, B); PIN(sacc); PIN(PWN); SBAR(); } while (0)
#define KRD(G, i) do { if (G) { kf[i] = KFR(sl_next, (i) >> 2, (i) & 3); SBAR(); } } while (0)
#define STEP(t, GK, GV, GL) do { SBAR(); \
    const lds_cptr vp_ = vp0 + sl_prev; u32x4 pn0, pn1, pn2, pn3; \
    { const float nm_ = -mhat; _Pragma("unroll") for (int r = 0; r < 16; ++r) { C0[r] = nm_; C1[r] = nm_; } } \
    GAPA(C0 = __builtin_amdgcn_mfma_f32_32x32x16_bf16(kf[0], qr[0], C0, 0, 0, 0), 0, 0); \
    GAPA(C1 = __builtin_amdgcn_mfma_f32_32x32x16_bf16(kf[4], qr[0], C1, 0, 0, 0), 4, 1); \
    GAPA(C0 = __builtin_amdgcn_mfma_f32_32x32x16_bf16(kf[1], qr[1], C0, 0, 0, 0), 1, 0); \
    GAPA(C1 = __builtin_amdgcn_mfma_f32_32x32x16_bf16(kf[5], qr[1], C1, 0, 0, 0), 5, 1); \
    GAPA(C0 = __builtin_amdgcn_mfma_f32_32x32x16_bf16(kf[2], qr[2], C0, 0, 0, 0), 2, 0); \
    GAPA(C1 = __builtin_amdgcn_mfma_f32_32x32x16_bf16(kf[6], qr[2], C1, 0, 0, 0), 6, 1); \
    GAPA(C0 = __builtin_amdgcn_mfma_f32_32x32x16_bf16(kf[3], qr[3], C0, 0, 0, 0), 3, 0); \
    GAPA(C1 = __builtin_amdgcn_mfma_f32_32x32x16_bf16(kf[7], qr[3], C1, 0, 0, 0), 7, 1); \
    if (GK) { DMA_K((t) + 3, sl_cur); } if (GV) { DMA_V((t) + 1, sl_next); } \
    { float a = MX3(C0[0], C0[1], C1[0]), b2 = MX3(C0[2], C0[3], C1[1]); a = MX3(a, C1[2], C1[3]); \
      _Pragma("unroll") for (int r = 4; r < 16; r += 4) { a = MX3(a, C0[r], C0[r + 1]); b2 = MX3(b2, C0[r + 2], C0[r + 3]); a = MX3(a, C1[r], C1[r + 1]); b2 = MX3(b2, C1[r + 2], C1[r + 3]); } \
      const float rm = swapmax(__builtin_fmaxf(a, b2)); \
      resc = false; \
      if (__builtin_expect(__any(rm > (float)ATTN_THR), 0)) { const float dl = __builtin_fmaxf(rm, 0.f); mhat += dl; \
        _Pragma("unroll") for (int r = 0; r < 16; ++r) { C0[r] -= dl; C1[r] -= dl; } \
        const float f = __builtin_amdgcn_exp2f(-dl); l_reg *= f; if (hi == 0) wsf[r32] = f; resc = true; } } \
    float sacc = 0.f; \
    SBAR(); \
    GAPB(o[0] = __builtin_amdgcn_mfma_f32_32x32x16_bf16(PAF(0), VFR(0), o[0], 0, 0, 0), C0, 0, pn0, 0);  VRD(0, 2); SBAR(); \
    GAPB(o[1] = __builtin_amdgcn_mfma_f32_32x32x16_bf16(PAF(0), VFR(4), o[1], 0, 0, 0), C0, 2, pn0, 1);  VRD(4, 3); SBAR(); \
    GAPB(o[0] = __builtin_amdgcn_mfma_f32_32x32x16_bf16(PAF(1), VFR(1), o[0], 0, 0, 0), C0, 4, pn0, 2);  VRD(1, 2); SBAR(); \
    GAPB(o[1] = __builtin_amdgcn_mfma_f32_32x32x16_bf16(PAF(1), VFR(5), o[1], 0, 0, 0), C0, 6, pn0, 3);  VRD(5, 3); SBAR(); \
    GAPB(o[0] = __builtin_amdgcn_mfma_f32_32x32x16_bf16(PAF(2), VFR(2), o[0], 0, 0, 0), C0, 8, pn1, 0);  VRD(2, 2); SBAR(); \
    GAPB(o[1] = __builtin_amdgcn_mfma_f32_32x32x16_bf16(PAF(2), VFR(6), o[1], 0, 0, 0), C0, 10, pn1, 1); VRD(6, 3); SBAR(); \
    GAPB(o[0] = __builtin_amdgcn_mfma_f32_32x32x16_bf16(PAF(3), VFR(3), o[0], 0, 0, 0), C0, 12, pn1, 2); VRD(3, 2); SBAR(); \
    GAPB(o[1] = __builtin_amdgcn_mfma_f32_32x32x16_bf16(PAF(3), VFR(7), o[1], 0, 0, 0), C0, 14, pn1, 3); VRD(7, 3); SBAR(); \
    KRD(GL, 0); GAPB(o[2] = __builtin_amdgcn_mfma_f32_32x32x16_bf16(PAF(0), VFR(0), o[2], 0, 0, 0), C1, 0, pn2, 0); \
    KRD(GL, 1); GAPB(o[3] = __builtin_amdgcn_mfma_f32_32x32x16_bf16(PAF(0), VFR(4), o[3], 0, 0, 0), C1, 2, pn2, 1); \
    KRD(GL, 2); GAPB(o[2] = __builtin_amdgcn_mfma_f32_32x32x16_bf16(PAF(1), VFR(1), o[2], 0, 0, 0), C1, 4, pn2, 2); \
    KRD(GL, 3); GAPB(o[3] = __builtin_amdgcn_mfma_f32_32x32x16_bf16(PAF(1), VFR(5), o[3], 0, 0, 0), C1, 6, pn2, 3); \
    KRD(GL, 4); GAPB(o[2] = __builtin_amdgcn_mfma_f32_32x32x16_bf16(PAF(2), VFR(2), o[2], 0, 0, 0), C1, 8, pn3, 0); \
    KRD(GL, 5); GAPB(o[3] = __builtin_amdgcn_mfma_f32_32x32x16_bf16(PAF(2), VFR(6), o[3], 0, 0, 0), C1, 10, pn3, 1); \
    KRD(GL, 6); GAPB(o[2] = __builtin_amdgcn_mfma_f32_32x32x16_bf16(PAF(3), VFR(3), o[2], 0, 0, 0), C1, 12, pn3, 2); \
    KRD(GL, 7); GAPB(o[3] = __builtin_amdgcn_mfma_f32_32x32x16_bf16(PAF(3), VFR(7), o[3], 0, 0, 0), C1, 14, pn3, 3); \
    l_reg += sacc; pw0 = pn0; pw1 = pn1; pw2 = pn2; pw3 = pn3; \
    } while (0)
#define DRAIN(slot) do { const lds_cptr vp_ = vp0 + (slot); \
    _Pragma("unroll") for (int dd = 0; dd < 4; dd += 2) { \
      _Pragma("unroll") for (int i = 0; i < 8; ++i) VRD(i, dd + (i >> 2)); \
      o[dd] = __builtin_amdgcn_mfma_f32_32x32x16_bf16(PAF(0), VFR(0), o[dd], 0, 0, 0); o[dd + 1] = __builtin_amdgcn_mfma_f32_32x32x16_bf16(PAF(0), VFR(4), o[dd + 1], 0, 0, 0); \
      o[dd] = __builtin_amdgcn_mfma_f32_32x32x16_bf16(PAF(1), VFR(1), o[dd], 0, 0, 0); o[dd + 1] = __builtin_amdgcn_mfma_f32_32x32x16_bf16(PAF(1), VFR(5), o[dd + 1], 0, 0, 0); \
      o[dd] = __builtin_amdgcn_mfma_f32_32x32x16_bf16(PAF(2), VFR(2), o[dd], 0, 0, 0); o[dd + 1] = __builtin_amdgcn_mfma_f32_32x32x16_bf16(PAF(2), VFR(6), o[dd + 1], 0, 0, 0); \
      o[dd] = __builtin_amdgcn_mfma_f32_32x32x16_bf16(PAF(3), VFR(3), o[dd], 0, 0, 0); o[dd + 1] = __builtin_amdgcn_mfma_f32_32x32x16_bf16(PAF(3), VFR(7), o[dd + 1], 0, 0, 0); } \
    } while (0)
    int t = 1;
    for (; t + 3 < NT; ++t) { STEP(t, true, true, true); WAIT_BAR(4); RESC(); ROT(); }
    for (; t < NT - 1; ++t) { STEP(t, false, true, true); WAIT_BAR(0); RESC(); ROT(); }
    if (NTW == NT) { STEP(t, false, false, false); RESC(); DRAIN(sl_cur); }
    else DRAIN(sl_prev);
    l_reg = swapsum(l_reg);
    { const float fac = (c == 0 ? 1.0f : lam) / l_reg; if (hi == 0) wsf[32 + r32] = fac; }
    asm volatile("s_waitcnt lgkmcnt(0)" ::: "memory");
#pragma unroll
    for (int r = 0; r < 16; ++r) { const float f = wsf[32 + crow(r, hi)];
#pragma unroll
        for (int d = 0; d < 4; ++d) o[d][r] *= f; }
    WAIT_BAR(0);
    LAS float* stg = (LAS float*)shm + rg * (32 * STG_ROW);
    if (c == 1) {
#pragma unroll
        for (int d = 0; d < 4; ++d)
#pragma unroll
            for (int r = 0; r < 16; ++r) stg[crow(r, hi) * STG_ROW + d * 32 + r32] = o[d][r];
    }
    WAIT_BAR(0);
    if (c == 0) {
#pragma unroll
        for (int d = 0; d < 4; ++d)
#pragma unroll
            for (int r = 0; r < 16; ++r) { LAS float* a = stg + crow(r, hi) * STG_ROW + d * 32 + r32; *a = o[d][r] - *a; }
        asm volatile("s_waitcnt lgkmcnt(0)" ::: "memory");
        const int row = lane >> 1, half = lane & 1;
        const LAS f32x4* src = (const LAS f32x4*)(stg + row * STG_ROW + half * 64);
        f32x4 v[16]; float ss = 0.f;
#pragma unroll
        for (int i = 0; i < 16; ++i) { v[i] = src[i]; ss += (v[i].x * v[i].x + v[i].y * v[i].y) + (v[i].z * v[i].z + v[i].w * v[i].w); }
        ss += __shfl_xor(ss, 1);
        const float rn = rsqrtf(ss * (1.0f / 128.0f) + SUBLN_EPS) * (1.0f - LAMBDA_INIT);
        const f32x4* g4 = (const f32x4*)(subg + half * 64);
        bf16_t* orow = O + (rowbase + q0 + rg * 32 + row) * DM + h * 128 + half * 64;
#pragma unroll
        for (int i = 0; i < 8; ++i) { const f32x4 a = v[2 * i] * rn * g4[2 * i], bq = v[2 * i + 1] * rn * g4[2 * i + 1]; *(u32x4*)(orow + 8 * i) = pk8(a, bq); }
    }
    asm volatile("s_waitcnt vmcnt(0)" ::: "memory");
    WAIT_BAR(0);
#undef DMA_K
#undef DMA_V
#undef KFR
#undef ROT
#undef RESC
#undef PKW
#undef PAF
#undef VFR
#undef PIN
#undef MX3
#undef EX
#undef VRD
#undef GAPA
#undef GAPB
#undef KRD
#undef STEP
#undef DRAIN
}
#undef SBAR
#undef WAIT_BAR
__device__ __forceinline__ void attn_phase(const Params& p, LAS unsigned char* lds, int vcu) {
    const bf16_t* Q = (const bf16_t*)(p.ws + WS_Q); const bf16_t* K = (const bf16_t*)(p.ws + WS_K); const bf16_t* V = (const bf16_t*)(p.ws + WS_V);
    const float lam = ((const float*)(p.ws + WS_PAR))[0];
    const int bh = vcu >> 2, qq = vcu & 3;
    for (int i = 0; i < 8; ++i) { const int s = qq + 4 * (i >> 1); const int j = (i & 1) ? 31 - s : s;
        attn_unit(bh >> 3, bh & 7, j, Q, K, V, (bf16_t*)(p.ws + WS_O), p.in[I_SUBG], lam, lds); }
}
}

__device__ __forceinline__ void attn_simple_unit(const Params& p, LAS float* sm, int wg) {
    LAS float* Qs = sm; LAS float* Ks = Qs + 64 * 129; LAS float* Vs = Ks + 64 * 129; LAS float* Ss = Vs + 64 * 128; LAS float* scl = Ss + 2 * 64 * 65; LAS float* linv = scl + 128;
    const int tid = threadIdx.x;
    const int qc = 63 - (wg >> 6), bh = wg & 63, b = bh >> 3, h = bh & 7;
    const bf16_t* Qg = (const bf16_t*)(p.ws + WS_Q); const bf16_t* Kg = (const bf16_t*)(p.ws + WS_K); const bf16_t* Vg = (const bf16_t*)(p.ws + WS_V);
    bf16_t* Og = (bf16_t*)(p.ws + WS_O);
    const float lam = ((const float*)(p.ws + WS_PAR))[0];
    const size_t rowq = (size_t)b * SEQ + qc * 64;
    __syncthreads();
#pragma unroll
    for (int i = 0; i < 2; ++i) { const int idx = tid + 512 * i, row = idx >> 4, pc = idx & 15; float f[8]; unpk8(*(const u32x4*)(Qg + (rowq + row) * DM + h * 128 + pc * 8), f);
#pragma unroll
        for (int e = 0; e < 8; ++e) Qs[row * 129 + pc * 8 + e] = f[e]; }
    const int r = tid >> 3, part = tid & 7;
    float o1[16], o2[16];
#pragma unroll
    for (int j = 0; j < 16; ++j) { o1[j] = 0.f; o2[j] = 0.f; }
    float mrun = -INFINITY, lrun = 0.f;
    for (int jt = 0; jt <= qc; ++jt) {
        const size_t rowk = (size_t)b * SEQ + jt * 64;
        __syncthreads();
#pragma unroll
        for (int i = 0; i < 2; ++i) { const int idx = tid + 512 * i, row = idx >> 4, pc = idx & 15; float f[8];
            unpk8(*(const u32x4*)(Kg + (rowk + row) * DM + h * 128 + pc * 8), f);
#pragma unroll
            for (int e = 0; e < 8; ++e) Ks[row * 129 + pc * 8 + e] = f[e];
            unpk8(*(const u32x4*)(Vg + (rowk + row) * DM + h * 128 + pc * 8), f);
#pragma unroll
            for (int e = 0; e < 8; ++e) Vs[row * 128 + pc * 8 + e] = f[e]; }
        __syncthreads();
#pragma unroll
        for (int c = 0; c < 2; ++c) {
            float acc[8];
#pragma unroll
            for (int kk = 0; kk < 8; ++kk) acc[kk] = 0.f;
            for (int d = 0; d < 64; ++d) { const float qv = Qs[r * 129 + c * 64 + d];
#pragma unroll
                for (int kk = 0; kk < 8; ++kk) acc[kk] += qv * Ks[(part * 8 + kk) * 129 + c * 64 + d]; }
#pragma unroll
            for (int kk = 0; kk < 8; ++kk) Ss[(c * 64 + r) * 65 + part * 8 + kk] = acc[kk];
        }
        __syncthreads();
        if (tid < 128) { LAS float* s = Ss + tid * 65; float mx = -INFINITY;
            for (int k = 0; k < 64; ++k) mx = fmaxf(mx, s[k]);
            const float mn = fmaxf(mrun, mx), sc = exp2f(mrun - mn); float sum = 0.f;
            for (int k = 0; k < 64; ++k) { const float e = exp2f(s[k] - mn); s[k] = e; sum += e; }
            lrun = lrun * sc + sum; mrun = mn; scl[tid] = sc; }
        __syncthreads();
        { const float s1 = scl[r], s2 = scl[64 + r];
#pragma unroll
          for (int j = 0; j < 16; ++j) { o1[j] *= s1; o2[j] *= s2; }
          for (int k = 0; k < 64; ++k) { const float p1 = Ss[r * 65 + k], p2 = Ss[(64 + r) * 65 + k];
#pragma unroll
              for (int j4 = 0; j4 < 4; ++j4) { const f32x4 v = *(const LAS f32x4*)&Vs[k * 128 + part * 16 + 4 * j4];
#pragma unroll
                  for (int e = 0; e < 4; ++e) { o1[4 * j4 + e] += p1 * v[e]; o2[4 * j4 + e] += p2 * v[e]; } } } }
    }
    __syncthreads();
    if (tid < 128) linv[tid] = 1.0f / lrun;
    __syncthreads();
    { const float i1 = linv[r], i2 = linv[64 + r] * lam; float ss = 0.f;
#pragma unroll
      for (int j = 0; j < 16; ++j) { o1[j] = o1[j] * i1 - o2[j] * i2; ss += o1[j] * o1[j]; }
      ss += __shfl_xor(ss, 1); ss += __shfl_xor(ss, 2); ss += __shfl_xor(ss, 4);
      const float rn = rsqrtf(ss * (1.0f / 128.0f) + SUBLN_EPS) * (1.0f - LAMBDA_INIT);
      const float* g = p.in[I_SUBG] + part * 16;
      bf16_t* orow = Og + (rowq + r) * DM + h * 128 + part * 16;
#pragma unroll
      for (int j8 = 0; j8 < 2; ++j8) { f32x4 a, bq;
#pragma unroll
          for (int e = 0; e < 4; ++e) { a[e] = o1[8 * j8 + e] * rn * g[8 * j8 + e]; bq[e] = o1[8 * j8 + 4 + e] * rn * g[8 * j8 + 4 + e]; }
          *(u32x4*)(orow + 8 * j8) = pk8(a, bq); } }
}
__device__ __forceinline__ void conv_phase(const Params& p, int gtid, int nthreads) {
    const bf16_t* XP = (const bf16_t*)(p.ws + WS_XP); bf16_t* XC = (bf16_t*)(p.ws + WS_XC);
    const float* cw = p.in[I_CONVW]; const float* cb = p.in[I_CONVB];
    for (int it = gtid; it < (M / 16) * 128; it += nthreads) {
        const int c = (it & 127) * 8, r0 = (it >> 7) * 16;
        float w[4][8], bias[8];
#pragma unroll
        for (int j = 0; j < 4; ++j) { const f32x4 a = *(const f32x4*)(cw + j * DM + c), b = *(const f32x4*)(cw + j * DM + c + 4);
#pragma unroll
            for (int e = 0; e < 4; ++e) { w[j][e] = a[e]; w[j][4 + e] = b[e]; } }
        { const f32x4 a = *(const f32x4*)(cb + c), b = *(const f32x4*)(cb + c + 4);
#pragma unroll
          for (int e = 0; e < 4; ++e) { bias[e] = a[e]; bias[4 + e] = b[e]; } }
        float x0[8], x1[8], x2[8];
        if ((r0 & (SEQ - 1)) != 0) { unpk8(*(const u32x4*)(XP + (size_t)(r0 - 3) * DM + c), x0); unpk8(*(const u32x4*)(XP + (size_t)(r0 - 2) * DM + c), x1); unpk8(*(const u32x4*)(XP + (size_t)(r0 - 1) * DM + c), x2); }
        else {
#pragma unroll
            for (int e = 0; e < 8; ++e) { x0[e] = 0.f; x1[e] = 0.f; x2[e] = 0.f; } }
#pragma unroll
        for (int i = 0; i < 16; ++i) { float x3[8]; unpk8(*(const u32x4*)(XP + (size_t)(r0 + i) * DM + c), x3); float acc[8];
#pragma unroll
            for (int e = 0; e < 8; ++e) acc[e] = bias[e] + w[0][e] * x0[e] + w[1][e] * x1[e] + w[2][e] * x2[e] + w[3][e] * x3[e];
            *(u32x4*)(XC + (size_t)(r0 + i) * DM + c) = pk8((f32x4){acc[0], acc[1], acc[2], acc[3]}, (f32x4){acc[4], acc[5], acc[6], acc[7]});
#pragma unroll
            for (int e = 0; e < 8; ++e) { x0[e] = x1[e]; x1[e] = x2[e]; x2[e] = x3[e]; } }
    }
}
__device__ __forceinline__ void scan_item(const Params& p, LAS float* sm, int item) {
    const unsigned* LAU = (const unsigned*)(p.ws + WS_LAU); const bf16_t* Y = (const bf16_t*)(p.ws + WS_Y); bf16_t* Gt = (bf16_t*)(p.ws + WS_G);
    const int tid = threadIdx.x, seg = tid >> 5, ch = tid & 31; const int b = item >> 5, cb = item & 31;
    const size_t base0 = (size_t)b * SEQ * DM + cb * 32 + ch;
    float carry = 0.f;
    __syncthreads();
    for (int chunk = 0; chunk < 16; ++chunk) {
        const size_t base = base0 + (size_t)(chunk * 256 + seg * 16) * DM;
        unsigned w[16]; bf16_t yv[16];
#pragma unroll
        for (int i = 0; i < 16; ++i) { w[i] = LAU[base + (size_t)i * DM]; yv[i] = Y[base + (size_t)i * DM]; }
        float av[16], h = 0.f, As = 0.f;
#pragma unroll
        for (int i = 0; i < 16; ++i) { const float la = bf2f(w[i] & 0xffffu); av[i] = __expf(la); As += la; h = av[i] * h + bf2f(w[i] >> 16); }
        LAS float* ex = sm + (chunk & 1) * 1024;
        ex[tid] = As; ex[512 + tid] = h;
        __syncthreads();
        float cur = carry, cin = 0.f;
#pragma unroll
        for (int s2 = 0; s2 < 16; ++s2) { if (s2 == seg) cin = cur; cur = __expf(ex[s2 * 32 + ch]) * cur + ex[512 + s2 * 32 + ch]; }
        carry = cur; h = cin;
#pragma unroll
        for (int i = 0; i < 16; ++i) { h = av[i] * h + bf2f(w[i] >> 16); Gt[base + (size_t)i * DM] = (bf16_t)f2bf(h * bf2f(yv[i])); }
    }
}
__device__ __forceinline__ void final_norm_phase(const Params& p, float* dst, int gw, int nw, int lane) {
    const f32x4* g4 = (const f32x4*)p.in[I_FING] + lane;
    for (int m = gw; m < M; m += nw) { const f32x4* xr = (const f32x4*)(p.out + (size_t)m * DM) + lane; f32x4* orow = (f32x4*)(dst + (size_t)m * DM) + lane; f32x4 v[4]; float s = 0.f;
#pragma unroll
        for (int j = 0; j < 4; ++j) { v[j] = xr[64 * j]; s += (v[j].x * v[j].x + v[j].y * v[j].y) + (v[j].z * v[j].z + v[j].w * v[j].w); }
        const float rs = rsqrtf(wave_sum(s) * (1.0f / DM) + NORM_EPS);
#pragma unroll
        for (int j = 0; j < 4; ++j) orow[64 * j] = v[j] * rs * g4[64 * j]; }
}

struct Args { Params p; int ph_lo, ph_hi, li, pad; };
__global__ void __launch_bounds__(NWAVES * 64, 2) mega(Args a) {
    extern __shared__ __attribute__((aligned(16))) unsigned char lds_raw[];
    LAS unsigned char* lds = (LAS unsigned char*)lds_raw;
    volatile LAS unsigned* MISC = (volatile LAS unsigned*)(lds + MISC_OFF);
    const int tid = threadIdx.x, lane = tid & 63, wave = __builtin_amdgcn_readfirstlane(tid >> 6);
    const int G = gridDim.x; const int bx = blockIdx.x; const int vcu = (G % 8 == 0) ? (bx % 8) * (G / 8) + bx / 8 : bx;
    unsigned char* ws = a.p.ws;
    for (int u = tid; u < (LDS_BYTES - LDSCTL_OFF) / 4; u += NWAVES * 64) ((LAS unsigned*)(lds + LDSCTL_OFF))[u] = 0u;
    __syncthreads();
    XcdBarrier bar = xcd_barrier_post((unsigned*)(ws + WS_CTL) + CW_BAR + a.li * XCD_BAR_WORDS, MISC + 8);
    const int lo = a.ph_lo, hi = a.ph_hi;
#define IN(k) (lo <= (k) && (k) < hi)
#define SEAM(k) do { if (IN(k) && IN((k) + 1)) xcd_barrier(bar); } while (0)
    float* ssq = (float*)(ws + WS_SSQ); float* par = (float*)(ws + WS_PAR);
    const float* cosT = (const float*)(ws + WS_ROPE); const float* sinT = cosT + 4096 * 32;
    bf16_t* XB = (bf16_t*)(ws + WS_XB);
#define GEMM_PHASE(ET, EOBJ, AP, LDA, BP, LDB, NN, KK, AGRP) do { pg8::Gemm g{(const bf16_t*)(AP), (const bf16_t*)(BP), M, NN, KK, LDA, LDB, AGRP}; pg8::StaticOrder S; S.init(M, NN, G, bx); \
        pg8::EpiAdapt<ET> E{EOBJ}; pg8::gemm_phase<pg8::EpiAdapt<ET>, pg8::StaticOrder, true, true>(lds, g, S, E); } while (0)
#ifndef DUP_PHASE
#define DUP_PHASE (-1)
#endif
#define REPS(k) for (int rep_ = (DUP_PHASE == (k)) ? 0 : 1; rep_ < 2; ++rep_)
#define FIRST_OF_DUP (rep_ == 0)
    float* dummy_f32 = (float*)(ws + WS_DUMMY);
    if (IN(0)) { REPS(0) prologue_work(a.p, vcu * NWAVES + wave, G * NWAVES, lane); SEAM(0); }
    if (IN(1)) { REPS(1) GEMM_PHASE(EpiQKV, (EpiQKV{ssq, cosT, sinT, (bf16_t*)(ws + WS_Q)}), XB, DM, ws + WS_WQKV, DM, 3072, DM, 0); SEAM(1); }
#if defined(SIMPLE_ATTN)
    if (IN(2)) { for (int wg = bx; wg < 4096; wg += G) attn_simple_unit(a.p, (LAS float*)lds, wg); __syncthreads(); SEAM(2); }
#else
    if (IN(2)) { REPS(2) attn::attn_phase(a.p, lds, vcu); SEAM(2); }
#endif
    if (IN(3)) { REPS(3) { if (FIRST_OF_DUP) GEMM_PHASE(EpiRes, (EpiRes{a.p.in[I_X], dummy_f32, nullptr, nullptr}), ws + WS_O, DM, ws + WS_WO, DM, DM, DM, 0);
                           else GEMM_PHASE(EpiRes, (EpiRes{a.p.in[I_X], a.p.out, XB, ssq + M}), ws + WS_O, DM, ws + WS_WO, DM, DM, DM, 0); } SEAM(3); }
    if (IN(4)) { REPS(4) GEMM_PHASE(EpiUp, (EpiUp{ssq + M, (bf16_t*)(ws + WS_H)}), XB, DM, ws + WS_W1, DM, FF, DM, 0); SEAM(4); }
    if (IN(5)) { REPS(5) { if (FIRST_OF_DUP) GEMM_PHASE(EpiRes, (EpiRes{a.p.out, dummy_f32, nullptr, nullptr}), ws + WS_H, FF, ws + WS_W2, FF, DM, FF, 0);
                           else GEMM_PHASE(EpiRes, (EpiRes{a.p.out, a.p.out, XB, ssq + 2 * M}), ws + WS_H, FF, ws + WS_W2, FF, DM, FF, 0); } SEAM(5); }
    if (IN(6)) { REPS(6) GEMM_PHASE(EpiRecIn, (EpiRecIn{ssq + 2 * M, (bf16_t*)(ws + WS_Y), (bf16_t*)(ws + WS_XP)}), XB, DM, ws + WS_WYX, DM, 2048, DM, 0); SEAM(6); }
    if (IN(7)) { REPS(7) conv_phase(a.p, vcu * (NWAVES * 64) + tid, G * (NWAVES * 64)); SEAM(7); }
    if (IN(8)) { REPS(8) GEMM_PHASE(EpiGates, (EpiGates{a.p.in[I_RBA], a.p.in[I_RBI], par + 256, (const bf16_t*)(ws + WS_XC), (bf16_t*)(ws + WS_LAU)}), ws + WS_XC, DM, ws + WS_WG, 256, 2048, 256, 1); SEAM(8); }
    if (IN(9)) { REPS(9) { for (int it = bx; it < BATCH * 32; it += G) scan_item(a.p, (LAS float*)lds, it); __syncthreads(); } SEAM(9); }
    if (IN(10)) { REPS(10) { if (FIRST_OF_DUP) GEMM_PHASE(EpiRes, (EpiRes{a.p.out, dummy_f32, nullptr, nullptr}), ws + WS_G, DM, ws + WS_WRO, DM, DM, DM, 0);
                             else GEMM_PHASE(EpiRes, (EpiRes{a.p.out, a.p.out, XB, ssq + 3 * M}), ws + WS_G, DM, ws + WS_WRO, DM, DM, DM, 0); } SEAM(10); }
    if (IN(11)) { REPS(11) GEMM_PHASE(EpiUp, (EpiUp{ssq + 3 * M, (bf16_t*)(ws + WS_H)}), XB, DM, ws + WS_W1 + 8 * MiB, DM, FF, DM, 0); SEAM(11); }
    if (IN(12)) { REPS(12) { if (FIRST_OF_DUP) GEMM_PHASE(EpiRes, (EpiRes{a.p.out, dummy_f32, nullptr, nullptr}), ws + WS_H, FF, ws + WS_W2 + 8 * MiB, FF, DM, FF, 0);
                             else GEMM_PHASE(EpiRes, (EpiRes{a.p.out, a.p.out, nullptr, nullptr}), ws + WS_H, FF, ws + WS_W2 + 8 * MiB, FF, DM, FF, 0); } SEAM(12); }
    if (IN(13)) { REPS(13) final_norm_phase(a.p, FIRST_OF_DUP ? dummy_f32 : a.p.out, vcu * NWAVES + wave, G * NWAVES, lane); }
#undef IN
#undef SEAM
#undef GEMM_PHASE
#undef REPS
#undef FIRST_OF_DUP
}

extern "C" void kernel_launch(void* const* d_in, const int* in_sizes, int n_in, void* d_out, int out_size, void* d_ws, size_t ws_size, hipStream_t stream) {
    static int grid = 0;
    if (grid == 0) {
        if (n_in != 23 || in_sizes[0] != M * DM || out_size != M * DM || ws_size < WS_END + (DUP_PHASE >= 0 ? 128 * MiB : 0)) { fprintf(stderr, "kernel_launch: unexpected shapes (n_in %d, in0 %d, out %d, ws %zu)\n", n_in, n_in > 0 ? in_sizes[0] : -1, out_size, ws_size); grid = -1; return; }
        if (hipFuncSetAttribute((const void*)mega, hipFuncAttributeMaxDynamicSharedMemorySize, LDS_BYTES) != hipSuccess) { fprintf(stderr, "kernel_launch: hipFuncSetAttribute(mega) failed\n"); grid = -1; return; }
        int dev = 0, cus = 0, per_cu = 0;
        if (hipGetDevice(&dev) != hipSuccess || hipDeviceGetAttribute(&cus, hipDeviceAttributeMultiprocessorCount, dev) != hipSuccess) { grid = -1; return; }
        if (hipOccupancyMaxActiveBlocksPerMultiprocessor(&per_cu, (const void*)mega, NWAVES * 64, LDS_BYTES) != hipSuccess || per_cu < 1) { fprintf(stderr, "kernel_launch: occupancy query says %d blocks per CU\n", per_cu); grid = -1; (void)hipGetLastError(); return; }
        grid = cus;
        if (grid != 256) fprintf(stderr, "kernel_launch: note: %d CUs\n", grid);
    }
    if (grid < 0) return;
    Args a{};
    for (int i = 0; i < 23; ++i) a.p.in[i] = (const float*)d_in[i];
    a.p.out = (float*)d_out; a.p.ws = (unsigned char*)d_ws;
    (void)hipMemsetAsync((unsigned char*)d_ws + WS_CTL, 0, CTL_ZERO_BYTES, stream);
    a.ph_lo = 0; a.ph_hi = NPH; a.li = 0;
    hipLaunchKernelGGL(mega, dim3(grid), dim3(NWAVES * 64), LDS_BYTES, stream, a);
}
```
